# Optimizing an MI355X kernel written in HIP

```python
import math
import jax, jax.numpy as jnp
from jax import lax
import numpy as np

D_MODEL = 4096
BATCH = 4
SEQ = 4096
DEPTH = 1

CHUNK = 64
EPS = 1e-6
GDN_HEADS = 16
GDN_DK = 128
GDN_DV = 128
CONV_K = 4
GDN_QK_W = GDN_HEADS * GDN_DK
GDN_V_W = GDN_HEADS * GDN_DV
GDN_CONV_W = 2 * GDN_QK_W + GDN_V_W
FOX_HEADS = 16
FOX_DH = 128
FOX_W = FOX_HEADS * FOX_DH
Q_BLOCK = 128
D_FF = -(-8 * D_MODEL // (3 * 256)) * 256
IN_SPLITS = (GDN_QK_W, GDN_QK_W, GDN_V_W, GDN_V_W, GDN_HEADS, GDN_HEADS,
             FOX_W, FOX_W, FOX_W, FOX_HEADS, D_MODEL, D_MODEL)
N_IN = sum(IN_SPLITS)

kernel_name = "hybrid_gdn_fox_gated_merge_swiglu"


def rmsnorm(x, w):
    xf = x.astype(jnp.float32)
    y = xf * lax.rsqrt(jnp.mean(xf * xf, axis=-1, keepdims=True) + EPS) * w.astype(jnp.float32)
    return y.astype(x.dtype)


def l2norm(x):
    return x * lax.rsqrt(jnp.sum(x * x, axis=-1, keepdims=True) + EPS)


def split_cols(p):
    idx, acc = [], 0
    for s in IN_SPLITS[:-1]:
        acc += s
        idx.append(acc)
    return jnp.split(p, idx, axis=-1)


def causal_conv(x, w):
    T = x.shape[1]
    xp = jnp.pad(x, ((0, 0), (CONV_K - 1, 0), (0, 0)))
    y = xp[:, 0:T] * w[0]
    for i in range(1, CONV_K):
        y = y + xp[:, i:i + T] * w[i]
    return y


def gated_delta_rule(q, k, v, g, beta):
    f32 = jnp.float32
    q, k, v, g, beta = (a.astype(f32) for a in (q, k, v, g, beta))
    Bn, T, H, DK = q.shape
    DV = v.shape[-1]
    N = T // CHUNK

    def to_chunks(a):
        a = jnp.moveaxis(a, 2, 1)
        return a.reshape(a.shape[:2] + (N, CHUNK) + a.shape[3:])

    qc = to_chunks(l2norm(q) * DK ** -0.5)
    kc = to_chunks(l2norm(k))
    vc = to_chunks(v)
    bc = to_chunks(beta)
    gc = jnp.cumsum(to_chunks(g), axis=-1)

    tril_incl = jnp.tril(jnp.ones((CHUNK, CHUNK), bool))
    tril_strict = jnp.tril(jnp.ones((CHUNK, CHUNK), bool), k=-1)
    decay = jnp.exp(jnp.where(tril_incl, gc[..., :, None] - gc[..., None, :], -jnp.inf))

    a_strict = jnp.where(tril_strict,
                         jnp.einsum('bhncd,bhnmd->bhncm', kc, kc) * decay * bc[..., :, None], 0.0)
    eye = jnp.eye(CHUNK, dtype=f32)
    rhs = jnp.concatenate([vc * bc[..., None], kc * (bc * jnp.exp(gc))[..., None]], axis=-1)
    uw = lax.linalg.triangular_solve(a_strict + eye, rhs, left_side=True, lower=True)
    u, w = uw[..., :DV], uw[..., DV:]
    qk = jnp.einsum('bhncd,bhnmd->bhncm', qc, kc) * decay

    def step(S, inp):
        q_i, k_i, u_i, w_i, g_i, qk_i = inp
        v_new = u_i - jnp.einsum('bhcd,bhdv->bhcv', w_i, S)
        o = (jnp.einsum('bhcd,bhdv->bhcv', q_i * jnp.exp(g_i)[..., None], S)
             + jnp.einsum('bhcm,bhmv->bhcv', qk_i, v_new))
        g_last = g_i[..., -1]
        S = (S * jnp.exp(g_last)[..., None, None]
             + jnp.einsum('bhcd,bhcv->bhdv', k_i * jnp.exp(g_last[..., None] - g_i)[..., None], v_new))
        return S, o

    xs = tuple(jnp.moveaxis(a, 2, 0) for a in (qc, kc, u, w, gc, qk))
    S0 = jnp.zeros((Bn, H, DK, DV), f32)
    _, o = lax.scan(step, S0, xs)
    o = jnp.transpose(o, (1, 0, 3, 2, 4))
    return o.reshape(Bn, T, H, DV)


def forgetting_attention(q, k, v, f_logit):
    T = q.shape[1]
    scale = FOX_DH ** -0.5
    c = jnp.cumsum(jax.nn.log_sigmoid(f_logit.astype(jnp.float32)), axis=1)
    q, k, v = (jnp.swapaxes(a, 1, 2) for a in (q, k, v))
    c = jnp.swapaxes(c, 1, 2)
    outs = []
    for i in range(T // Q_BLOCK):
        lo, hi = i * Q_BLOCK, (i + 1) * Q_BLOCK
        s = jnp.einsum('bhqd,bhkd->bhqk', q[:, :, lo:hi], k[:, :, :hi]).astype(jnp.float32) * scale
        s = s + c[:, :, lo:hi, None] - c[:, :, None, :hi]
        causal = jnp.arange(lo, hi)[:, None] >= jnp.arange(hi)[None, :]
        p = jax.nn.softmax(jnp.where(causal, s, -jnp.inf), axis=-1)
        outs.append(jnp.einsum('bhqk,bhkd->bhqd', p.astype(v.dtype), v[:, :, :hi]))
    o = jnp.concatenate(outs, axis=2)
    return jnp.swapaxes(o, 1, 2)


def hybrid_layer(x, norm_mix_w, w_in, conv_w, a_log, dt_bias, gdn_norm_w, fox_b_f,
                 fox_q_norm_w, fox_k_norm_w, w_branch_a, w_branch_b, w_out,
                 norm_ffn_w, w_ffn_gate, w_ffn_up, w_ffn_down):
    Bn, T, _ = x.shape
    xn = rmsnorm(x, norm_mix_w)
    (qa, ka, va, za, beta_logit, alpha_logit, qb, kb, vb, f_logit,
     gate_a_logit, gate_b_logit) = split_cols(xn @ w_in)

    qkv_a = jax.nn.silu(causal_conv(jnp.concatenate([qa, ka, va], axis=-1), conv_w))
    qa, ka, va = jnp.split(qkv_a, [GDN_QK_W, 2 * GDN_QK_W], axis=-1)
    beta = jax.nn.sigmoid(beta_logit.astype(jnp.float32))
    g = -jnp.exp(a_log.astype(jnp.float32)) * jax.nn.softplus(
        alpha_logit.astype(jnp.float32) + dt_bias.astype(jnp.float32))
    o_a = gated_delta_rule(qa.reshape(Bn, T, GDN_HEADS, GDN_DK), ka.reshape(Bn, T, GDN_HEADS, GDN_DK),
                           va.reshape(Bn, T, GDN_HEADS, GDN_DV), g, beta)
    o_a = rmsnorm(o_a, gdn_norm_w) * jax.nn.silu(za.reshape(Bn, T, GDN_HEADS, GDN_DV).astype(jnp.float32))
    y_a = o_a.astype(x.dtype).reshape(Bn, T, GDN_V_W) @ w_branch_a

    qb = rmsnorm(qb.reshape(Bn, T, FOX_HEADS, FOX_DH), fox_q_norm_w)
    kb = rmsnorm(kb.reshape(Bn, T, FOX_HEADS, FOX_DH), fox_k_norm_w)
    o_b = forgetting_attention(qb, kb, vb.reshape(Bn, T, FOX_HEADS, FOX_DH), f_logit + fox_b_f)
    y_b = o_b.reshape(Bn, T, FOX_W) @ w_branch_b

    merged = jax.nn.sigmoid(gate_a_logit) * y_a + jax.nn.sigmoid(gate_b_logit) * y_b
    h = x + merged @ w_out

    hn = rmsnorm(h, norm_ffn_w)
    return h + (jax.nn.silu(hn @ w_ffn_gate) * (hn @ w_ffn_up)) @ w_ffn_down


def setup_inputs(seed: int = 0) -> dict:
    key = jax.random.key(seed)
    ks = jax.random.split(key, 18)
    L = DEPTH
    f32 = jnp.float32

    def nrm(k, shape, fan_in):
        return jax.random.normal(k, shape, f32) * fan_in ** -0.5

    def gain(k, n):
        return 1.0 + 0.02 * jax.random.normal(k, (L, n), f32)

    dt = jnp.exp(jax.random.uniform(ks[6], (L, GDN_HEADS), f32, math.log(1e-3), math.log(1e-1)))
    return {
        "x": jax.random.normal(ks[0], (BATCH, SEQ, D_MODEL), f32),
        "norm_mix_w": gain(ks[1], D_MODEL),
        "w_in": nrm(ks[2], (L, D_MODEL, N_IN), D_MODEL),
        "conv_w": nrm(ks[3], (L, CONV_K, GDN_CONV_W), CONV_K),
        "a_log": jnp.log(jax.random.uniform(ks[4], (L, GDN_HEADS), f32, 1.0, 16.0)),
        "dt_bias": dt + jnp.log(-jnp.expm1(-dt)),
        "gdn_norm_w": gain(ks[5], GDN_DV),
        "fox_b_f": jax.random.uniform(ks[7], (L, FOX_HEADS), f32, 1.0, 4.0),
        "fox_q_norm_w": gain(ks[8], FOX_DH),
        "fox_k_norm_w": gain(ks[9], FOX_DH),
        "w_branch_a": nrm(ks[10], (L, GDN_V_W, D_MODEL), GDN_V_W),
        "w_branch_b": nrm(ks[11], (L, FOX_W, D_MODEL), FOX_W),
        "w_out": nrm(ks[12], (L, D_MODEL, D_MODEL), D_MODEL),
        "norm_ffn_w": gain(ks[13], D_MODEL),
        "w_ffn_gate": nrm(ks[14], (L, D_MODEL, D_FF), D_MODEL),
        "w_ffn_up": nrm(ks[15], (L, D_MODEL, D_FF), D_MODEL),
        "w_ffn_down": nrm(ks[16], (L, D_FF, D_MODEL), D_FF),
    }


def reference(x, norm_mix_w, w_in, conv_w, a_log, dt_bias, gdn_norm_w, fox_b_f,
              fox_q_norm_w, fox_k_norm_w, w_branch_a, w_branch_b, w_out,
              norm_ffn_w, w_ffn_gate, w_ffn_up, w_ffn_down):
    h = x
    for l in range(DEPTH):
        h = hybrid_layer(h, norm_mix_w[l], w_in[l], conv_w[l], a_log[l], dt_bias[l], gdn_norm_w[l],
                         fox_b_f[l], fox_q_norm_w[l], fox_k_norm_w[l], w_branch_a[l], w_branch_b[l],
                         w_out[l], norm_ffn_w[l], w_ffn_gate[l], w_ffn_up[l], w_ffn_down[l])
    return h
```

```cpp
#include <hip/hip_runtime.h>
#include <cstdio>
#include <cstdint>
namespace pg8 {
#define PG8_LAS __attribute__((address_space(3)))
typedef unsigned short bf16_t;
typedef short bf16x8 __attribute__((ext_vector_type(8)));
typedef float f32x4 __attribute__((ext_vector_type(4)));
typedef unsigned u32x4 __attribute__((ext_vector_type(4)));
constexpr bool WIMG = true;
constexpr int BM = 256, BK = 64, HALF = 128, HTB = HALF * BK * 2  , STAGE_BYTES = 8 * HTB, NXCD = 8, WGM = 4;

__host__ __device__ __forceinline__ int lds_byte(int r, int c) { const int st = (r >> 4) * 2 + (c >> 5), rr = r & 15, cc = c & 31, ob = rr * 64 + cc * 2; return st * 1024 + (ob ^ (((ob >> 9) & 1) << 5)); }
__host__ __device__ __forceinline__ void stage_rc(int b, int& R, int& C) { const int st = b / 1024, sb = b % 1024, swz = sb ^ (((sb >> 9) & 1) << 5); R = (st >> 1) * 16 + swz / 64; C = (st & 1) * 32 + (swz % 64) / 2; }
__host__ __device__ __forceinline__ int perm32(int rho) { const int n = rho >> 4, i = rho & 15; return 8 * (i >> 2) + 4 * n + (i & 3); }

struct Unit { int pm, pn; };
struct Gemm { const bf16_t* A; const bf16_t* Bt; int M, N, K; };

struct StaticOrder {
    int nM, nN, nwg, G, c;
    __host__ __device__ void init(int M, int N, int G_, int c_) { nM = M / BM; nN = N / BM; nwg = nM * nN; G = G_; c = c_; }
    __host__ __device__ bool next(int i, Unit& u) const {
        const long L = (long)i * G + c; if (L >= nwg) return false;
        int wgid = (int)L; { const int q = nwg / NXCD, r = nwg % NXCD, xcd = wgid % NXCD, off = wgid / NXCD; wgid = (xcd < r ? xcd * (q + 1) : r * (q + 1) + (xcd - r) * q) + off; }
        const int nig = WGM * nN, gid = wgid / nig, fm = gid * WGM, gsz = (nM - fm) < WGM ? (nM - fm) : WGM;
        u.pm = fm + ((wgid % nig) % gsz); u.pn = (wgid % nig) / gsz; return true;
    }
    __device__ __forceinline__ void a_ready(const Unit&) const {}
    __device__ __forceinline__ void done(const Unit&) const {}
};

__device__ __forceinline__ unsigned cvt_pk_bf16(float lo, float hi) { unsigned r; asm volatile("v_cvt_pk_bf16_f32 %0, %1, %2" : "=v"(r) : "v"(lo), "v"(hi)); return r; }
__device__ __forceinline__ float bf_lo(unsigned w) { return __uint_as_float(w << 16); }
__device__ __forceinline__ float bf_hi(unsigned w) { return __uint_as_float(w & 0xffff0000u); }
__device__ __forceinline__ float sigmoid_f(float x) { return __builtin_amdgcn_rcpf(1.0f + __builtin_amdgcn_exp2f(-1.4426950408889634f * x)); }

struct EpiStoreBf16 {
    static constexpr bool PERM = true, AFTER_DRAIN = false;
    bf16_t* O; int ldc; const float* wq; const float* wk; PG8_LAS float* part; int qn_lo, qn_mid, qn_hi; float eps;
    __device__ __forceinline__ void operator()(const f32x4 (&acc)[2][2][4][2], const Unit& u, int wr, int wc, int fr, int fq) const {
        const int row0 = u.pm * BM + wr * 64 + fr, col0 = u.pn * BM + wc * 32 + 8 * fq;
        if (u.pn >= qn_lo && u.pn < qn_hi) {
            const float* wp = (u.pn < qn_mid ? wq : wk) + wc * 32 + 8 * fq;
            const f32x4 w0 = *(const f32x4*)wp, w1 = *(const f32x4*)(wp + 4);
#pragma unroll
            for (int ai = 0; ai < 2; ++ai)
#pragma unroll
                for (int m = 0; m < 4; ++m)
#pragma unroll
                    for (int bj = 0; bj < 2; ++bj) { const f32x4 v0 = acc[ai][bj][m][0], v1 = acc[ai][bj][m][1];
                        float ss = v0[0] * v0[0] + v0[1] * v0[1] + v0[2] * v0[2] + v0[3] * v0[3] + v1[0] * v1[0] + v1[1] * v1[1] + v1[2] * v1[2] + v1[3] * v1[3];
                        ss += __shfl_xor(ss, 16); ss += __shfl_xor(ss, 32);
                        if (fq == 0) part[(ai * HALF + wr * 64 + m * 16 + fr) * 8 + bj * 4 + wc] = ss; }
            asm volatile("s_waitcnt lgkmcnt(0)" ::: "memory"); __builtin_amdgcn_s_barrier(); asm volatile("" ::: "memory");
#pragma unroll
            for (int ai = 0; ai < 2; ++ai)
#pragma unroll
                for (int m = 0; m < 4; ++m) { bf16_t* rowp = O + (size_t)(row0 + ai * HALF + m * 16) * ldc + col0;
#pragma unroll
                    for (int bj = 0; bj < 2; ++bj) { const f32x4 p = *(const PG8_LAS f32x4*)(part + (ai * HALF + wr * 64 + m * 16 + fr) * 8 + bj * 4);
                        const float rs = 1.0f / sqrtf((p[0] + p[1] + p[2] + p[3]) * (1.0f / 128.0f) + eps);
                        const f32x4 v0 = acc[ai][bj][m][0], v1 = acc[ai][bj][m][1];
                        u32x4 w; w.x = cvt_pk_bf16(v0[0] * rs * w0[0], v0[1] * rs * w0[1]); w.y = cvt_pk_bf16(v0[2] * rs * w0[2], v0[3] * rs * w0[3]);
                        w.z = cvt_pk_bf16(v1[0] * rs * w1[0], v1[1] * rs * w1[1]); w.w = cvt_pk_bf16(v1[2] * rs * w1[2], v1[3] * rs * w1[3]);
                        *(u32x4*)(rowp + bj * HALF) = w; } }
            return;
        }
#pragma unroll
        for (int ai = 0; ai < 2; ++ai)
#pragma unroll
            for (int m = 0; m < 4; ++m) { bf16_t* rowp = O + (size_t)(row0 + ai * HALF + m * 16) * ldc + col0;
#pragma unroll
                for (int bj = 0; bj < 2; ++bj) { const f32x4 v0 = acc[ai][bj][m][0], v1 = acc[ai][bj][m][1];
                    u32x4 w; w.x = cvt_pk_bf16(v0[0], v0[1]); w.y = cvt_pk_bf16(v0[2], v0[3]); w.z = cvt_pk_bf16(v1[0], v1[1]); w.w = cvt_pk_bf16(v1[2], v1[3]);
                    *(u32x4*)(rowp + bj * HALF) = w; } }
    }
};
template <bool FIRST> struct EpiBranch {
    static constexpr bool PERM = true, AFTER_DRAIN = false;
    bf16_t* MG; int ldm; const bf16_t* G; int ldg;
    __device__ __forceinline__ void operator()(const f32x4 (&acc)[2][2][4][2], const Unit& u, int wr, int wc, int fr, int fq) const {
        const int row0 = u.pm * BM + wr * 64 + fr, col0 = u.pn * BM + wc * 32 + 8 * fq;
#pragma unroll
        for (int ai = 0; ai < 2; ++ai) {
            u32x4 gl[4][2], pl[4][2];
#pragma unroll
            for (int m = 0; m < 4; ++m)
#pragma unroll
                for (int bj = 0; bj < 2; ++bj) { const size_t r = (size_t)(row0 + ai * HALF + m * 16); const int c = col0 + bj * HALF;
                    gl[m][bj] = *(const u32x4*)(G + r * ldg + c); if (!FIRST) pl[m][bj] = *(const u32x4*)(MG + r * ldm + c); }
#pragma unroll
            for (int m = 0; m < 4; ++m)
#pragma unroll
                for (int bj = 0; bj < 2; ++bj) { const size_t r = (size_t)(row0 + ai * HALF + m * 16); const int c = col0 + bj * HALF;
                    const u32x4 g = gl[m][bj]; const f32x4 a0 = acc[ai][bj][m][0], a1 = acc[ai][bj][m][1];
                    float v[8];
                    v[0] = a0[0] * sigmoid_f(bf_lo(g.x)); v[1] = a0[1] * sigmoid_f(bf_hi(g.x)); v[2] = a0[2] * sigmoid_f(bf_lo(g.y)); v[3] = a0[3] * sigmoid_f(bf_hi(g.y));
                    v[4] = a1[0] * sigmoid_f(bf_lo(g.z)); v[5] = a1[1] * sigmoid_f(bf_hi(g.z)); v[6] = a1[2] * sigmoid_f(bf_lo(g.w)); v[7] = a1[3] * sigmoid_f(bf_hi(g.w));
                    if (!FIRST) { const u32x4 p = pl[m][bj];
                        v[0] += bf_lo(p.x); v[1] += bf_hi(p.x); v[2] += bf_lo(p.y); v[3] += bf_hi(p.y); v[4] += bf_lo(p.z); v[5] += bf_hi(p.z); v[6] += bf_lo(p.w); v[7] += bf_hi(p.w); }
                    u32x4 w; w.x = cvt_pk_bf16(v[0], v[1]); w.y = cvt_pk_bf16(v[2], v[3]); w.z = cvt_pk_bf16(v[4], v[5]); w.w = cvt_pk_bf16(v[6], v[7]);
                    *(u32x4*)(MG + r * ldm + c) = w; }
        }
    }
};
struct EpiResidToBf16 {
    static constexpr bool PERM = true, AFTER_DRAIN = false;
    const float* X; bf16_t* HB; int ld;
    __device__ __forceinline__ void operator()(const f32x4 (&acc)[2][2][4][2], const Unit& u, int wr, int wc, int fr, int fq) const {
        const int row0 = u.pm * BM + wr * 64 + fr, col0 = u.pn * BM + wc * 32 + 8 * fq;
#pragma unroll
        for (int ai = 0; ai < 2; ++ai) {
            f32x4 xv[4][2][2];
#pragma unroll
            for (int m = 0; m < 4; ++m)
#pragma unroll
                for (int bj = 0; bj < 2; ++bj) { const size_t off = (size_t)(row0 + ai * HALF + m * 16) * ld + col0 + bj * HALF;
                    xv[m][bj][0] = *(const f32x4*)(X + off); xv[m][bj][1] = *(const f32x4*)(X + off + 4); }
#pragma unroll
            for (int m = 0; m < 4; ++m)
#pragma unroll
                for (int bj = 0; bj < 2; ++bj) { const size_t off = (size_t)(row0 + ai * HALF + m * 16) * ld + col0 + bj * HALF;
                    const f32x4 v0 = xv[m][bj][0] + acc[ai][bj][m][0], v1 = xv[m][bj][1] + acc[ai][bj][m][1];
                    u32x4 w; w.x = cvt_pk_bf16(v0[0], v0[1]); w.y = cvt_pk_bf16(v0[2], v0[3]); w.z = cvt_pk_bf16(v1[0], v1[1]); w.w = cvt_pk_bf16(v1[2], v1[3]);
                    *(u32x4*)(HB + off) = w; }
        }
    }
};
struct EpiResidFromBf16 {
    static constexpr bool PERM = false, AFTER_DRAIN = false;
    const bf16_t* HB; float* OUT; int ld;
    __device__ __forceinline__ void operator()(const f32x4 (&acc)[2][2][4][2], const Unit& u, int wr, int wc, int fr, int fq) const {
        const int row0 = u.pm * BM + wr * 64 + fr, col0 = u.pn * BM + wc * 32 + 4 * fq;
        typedef unsigned u32x2 __attribute__((ext_vector_type(2)));
        u32x2 h[2][4][2][2];
#pragma unroll
        for (int ai = 0; ai < 2; ++ai)
#pragma unroll
            for (int m = 0; m < 4; ++m)
#pragma unroll
                for (int bj = 0; bj < 2; ++bj)
#pragma unroll
                    for (int n = 0; n < 2; ++n) h[ai][m][bj][n] = *(const u32x2*)(HB + (size_t)(row0 + ai * HALF + m * 16) * ld + col0 + bj * HALF + n * 16);
#pragma unroll
        for (int ai = 0; ai < 2; ++ai)
#pragma unroll
            for (int m = 0; m < 4; ++m)
#pragma unroll
                for (int bj = 0; bj < 2; ++bj)
#pragma unroll
                    for (int n = 0; n < 2; ++n) { const u32x2 hh = h[ai][m][bj][n];
                        const f32x4 hv = {bf_lo(hh.x), bf_hi(hh.x), bf_lo(hh.y), bf_hi(hh.y)};
                        *(f32x4*)(OUT + (size_t)(row0 + ai * HALF + m * 16) * ld + col0 + bj * HALF + n * 16) = hv + acc[ai][bj][m][n]; }
    }
};
struct EpiSwiglu {
    static constexpr bool PERM = true, AFTER_DRAIN = false;
    bf16_t* ACT; int ldc;
    __device__ __forceinline__ void operator()(const f32x4 (&acc)[2][2][4][2], const Unit& u, int wr, int wc, int fr, int fq) const {
        const int row0 = u.pm * BM + wr * 64 + fr, col0 = u.pn * HALF + wc * 32 + 8 * fq;
#pragma unroll
        for (int ai = 0; ai < 2; ++ai)
#pragma unroll
            for (int m = 0; m < 4; ++m) { bf16_t* rowp = ACT + (size_t)(row0 + ai * HALF + m * 16) * ldc + col0;
                float v[8];
#pragma unroll
                for (int n = 0; n < 2; ++n)
#pragma unroll
                    for (int j = 0; j < 4; ++j) { const float g = acc[ai][0][m][n][j], up = acc[ai][1][m][n][j]; v[4 * n + j] = g * sigmoid_f(g) * up; }
                u32x4 w; w.x = cvt_pk_bf16(v[0], v[1]); w.y = cvt_pk_bf16(v[2], v[3]); w.z = cvt_pk_bf16(v[4], v[5]); w.w = cvt_pk_bf16(v[6], v[7]);
                *(u32x4*)rowp = w; }
    }
};

template <class Epi, class Sched, bool ALIGN_EPI = false, bool SP2 = false>
__device__ __forceinline__ void gemm_phase(PG8_LAS unsigned char* lds, const Gemm g, const Sched& S, const Epi& E) {
    const int tid = threadIdx.x, wid = __builtin_amdgcn_readfirstlane(tid >> 6), lane = tid & 63, wr = wid >> 2, wc = wid & 3, fr = lane & 15, fq = lane >> 4;
    const int K = g.K, nt = K / BK;
    unsigned voffA[2], voffB[2];
#pragma unroll
    for (int i = 0; i < 2; ++i) { int R, C; stage_rc(tid * 16 + i * 8192, R, C); const int Rb = Epi::PERM ? ((R & ~31) + perm32(R & 31)) : R;
        voffA[i] = (unsigned)(R * K + C) * 2u; voffB[i] = WIMG ? (unsigned)(Rb * BK + C) * 2u : (unsigned)(Rb * K + C) * 2u; }
    const size_t kstep = (size_t)(BK * 2);
    const size_t hstep = (size_t)HALF * K * 2;
    const size_t tstep = 2 * hstep;
    const size_t kstepB = WIMG ? (size_t)(BM * BK * 2) : kstep, hstepB = WIMG ? (size_t)(HALF * BK * 2) : hstep;
    const unsigned ldsw = (unsigned)wid * 1024u;
    const int aoff = lds_byte(wr * 64 + fr, fq * 8), boff = lds_byte(wc * 32 + fr, fq * 8);
#define PG8_SA(b, h) (((b) * 2 + (h)) * HTB)
#define PG8_SB(b, h) ((4 + (b) * 2 + (h)) * HTB)
#define PG8_STAGE(bufoff, gbase, voff) do { _Pragma("unroll") for (int _i = 0; _i < 2; ++_i) \
        __builtin_amdgcn_global_load_lds((const unsigned*)((const char*)(gbase) + (voff)[_i]), (PG8_LAS unsigned*)(lds + (bufoff) + ldsw + _i * 8192), 16, 0, 0); } while (0)
#define PG8_LDA(dst, b, h) do { _Pragma("unroll") for (int m = 0; m < 4; ++m) _Pragma("unroll") for (int k = 0; k < 2; ++k) dst[m][k] = *(const PG8_LAS bf16x8*)(lds + PG8_SA(b, h) + aoff + m * 2048 + k * 1024); } while (0)
#define PG8_LDB(dst, b, h) do { _Pragma("unroll") for (int n = 0; n < 2; ++n) _Pragma("unroll") for (int k = 0; k < 2; ++k) dst[n][k] = *(const PG8_LAS bf16x8*)(lds + PG8_SB(b, h) + boff + n * 2048 + k * 1024); } while (0)
#define PG8_MMA(ai, bj, At, Bt) do { __builtin_amdgcn_s_setprio(1); _Pragma("unroll") for (int m = 0; m < 4; ++m) _Pragma("unroll") for (int n = 0; n < 2; ++n) _Pragma("unroll") for (int k = 0; k < 2; ++k) \
        acc[ai][bj][m][n] = __builtin_amdgcn_mfma_f32_16x16x32_bf16(Bt[n][k], At[m][k], acc[ai][bj][m][n], 0, 0, 0); __builtin_amdgcn_s_setprio(0); } while (0)
#define PG8_WAIT_V(n) asm volatile("s_waitcnt vmcnt(" #n ")" ::: "memory")
#define PG8_WAIT_L(n) asm volatile("s_waitcnt lgkmcnt(" #n ")" ::: "memory")
#define PG8_BAR __builtin_amdgcn_s_barrier()
#define PG8_SCHED __builtin_amdgcn_sched_barrier(0)
    Unit cur, nxt; int ui = 0;
    if (!S.next(0, cur)) return;
    f32x4 acc[2][2][4][2];
#pragma unroll
    for (int a = 0; a < 2; ++a)
#pragma unroll
        for (int b = 0; b < 2; ++b)
#pragma unroll
            for (int m = 0; m < 4; ++m)
#pragma unroll
                for (int n = 0; n < 2; ++n) acc[a][b][m][n] = (f32x4){0.f, 0.f, 0.f, 0.f};
    bf16x8 At[4][2], B0[2][2], B1[2][2];
    const char* cA = (const char*)g.A + (size_t)cur.pm * tstep; const char* cB = (const char*)g.Bt + (size_t)cur.pn * tstep;
    S.a_ready(cur);
    if constexpr (SP2) {
        PG8_STAGE(PG8_SB(0, 0), cB, voffB); PG8_STAGE(PG8_SB(0, 1), cB + hstepB, voffB); PG8_STAGE(PG8_SA(0, 0), cA, voffA); PG8_STAGE(PG8_SA(0, 1), cA + hstep, voffA);
        if (wr == 1) PG8_BAR;
        PG8_WAIT_V(2); PG8_BAR;
        PG8_STAGE(PG8_SB(1, 0), cB + kstepB, voffB); PG8_STAGE(PG8_SA(1, 0), cA + kstep, voffA); PG8_STAGE(PG8_SB(1, 1), cB + hstepB + kstepB, voffB);
        PG8_WAIT_V(6); PG8_BAR;
    } else {
        PG8_STAGE(PG8_SB(0, 0), cB, voffB); PG8_STAGE(PG8_SA(0, 0), cA, voffA); PG8_STAGE(PG8_SB(0, 1), cB + hstepB, voffB); PG8_STAGE(PG8_SA(0, 1), cA + hstep, voffA);
        if (wr == 1) PG8_BAR;
        PG8_WAIT_V(4); PG8_BAR;
        PG8_STAGE(PG8_SB(1, 0), cB + kstepB, voffB); PG8_STAGE(PG8_SA(1, 0), cA + kstep, voffA); PG8_STAGE(PG8_SB(1, 1), cB + hstepB + kstepB, voffB);
        PG8_WAIT_V(6); PG8_BAR;
    }
    for (;;) {
        const bool has_next = S.next(ui + 1, nxt);
        const char* nA = has_next ? (const char*)g.A + (size_t)nxt.pm * tstep : cA; const char* nB = has_next ? (const char*)g.Bt + (size_t)nxt.pn * tstep : cB;
        for (int t = 0; t < nt; t += 2) {
            const bool last = (t == nt - 2);
            const char* a1 = cA + (size_t)(t + 1) * kstep;
            const char* a2 = last ? nA : cA + (size_t)(t + 2) * kstep; const char* b2 = last ? nB : cB + (size_t)(t + 2) * kstepB;
            const char* a3 = a2 + kstep; const char* b3 = b2 + kstepB;
            if (last && has_next) S.a_ready(nxt);
            if constexpr (SP2) {
            PG8_LDB(B0, 0, 0); PG8_LDB(B1, 0, 1); PG8_SCHED; PG8_LDA(At, 0, 0); PG8_STAGE(PG8_SA(1, 1), a1 + hstep, voffA);
            PG8_WAIT_V(8); PG8_WAIT_L(0); PG8_BAR; PG8_MMA(0, 0, At, B0); PG8_MMA(0, 1, At, B1); PG8_BAR; PG8_SCHED;
            PG8_LDA(At, 0, 1); PG8_STAGE(PG8_SB(0, 0), b2, voffB); PG8_STAGE(PG8_SB(0, 1), b2 + hstepB, voffB); PG8_STAGE(PG8_SA(0, 0), a2, voffA);
            PG8_WAIT_V(8); PG8_WAIT_L(0); PG8_BAR; PG8_MMA(1, 0, At, B0); PG8_MMA(1, 1, At, B1); PG8_BAR; PG8_SCHED;
            PG8_LDB(B0, 1, 0); PG8_LDB(B1, 1, 1); PG8_SCHED; PG8_LDA(At, 1, 0); PG8_STAGE(PG8_SA(0, 1), a2 + hstep, voffA);
            PG8_WAIT_V(8); PG8_WAIT_L(0); PG8_BAR; PG8_MMA(0, 0, At, B0); PG8_MMA(0, 1, At, B1); PG8_BAR; PG8_SCHED;
            PG8_LDA(At, 1, 1); PG8_STAGE(PG8_SB(1, 0), b3, voffB); PG8_STAGE(PG8_SB(1, 1), b3 + hstepB, voffB); PG8_STAGE(PG8_SA(1, 0), a3, voffA);
            PG8_WAIT_V(8); PG8_WAIT_L(0); PG8_BAR; PG8_MMA(1, 0, At, B0); PG8_MMA(1, 1, At, B1); PG8_BAR; PG8_SCHED;
            } else {
            PG8_LDB(B0, 0, 0); PG8_SCHED; PG8_LDA(At, 0, 0); PG8_STAGE(PG8_SA(1, 1), a1 + hstep, voffA);
            PG8_WAIT_L(8); PG8_BAR; PG8_WAIT_L(0); PG8_MMA(0, 0, At, B0); PG8_BAR; PG8_SCHED;
            PG8_LDB(B1, 0, 1); PG8_STAGE(PG8_SB(0, 0), b2, voffB);
            PG8_BAR; PG8_WAIT_L(0); PG8_MMA(0, 1, At, B1); PG8_BAR;
            PG8_LDA(At, 0, 1); PG8_STAGE(PG8_SA(0, 0), a2, voffA);
            PG8_BAR; PG8_WAIT_L(0); PG8_MMA(1, 0, At, B0); PG8_BAR; PG8_SCHED;
            PG8_STAGE(PG8_SB(0, 1), b2 + hstepB, voffB);
            PG8_WAIT_V(6); PG8_BAR; PG8_MMA(1, 1, At, B1); PG8_BAR;
            PG8_LDB(B0, 1, 0); PG8_SCHED; PG8_LDA(At, 1, 0); PG8_STAGE(PG8_SA(0, 1), a2 + hstep, voffA);
            PG8_WAIT_L(8); PG8_BAR; PG8_WAIT_L(0); PG8_MMA(0, 0, At, B0); PG8_BAR; PG8_SCHED;
            PG8_LDB(B1, 1, 1); PG8_STAGE(PG8_SB(1, 0), b3, voffB);
            PG8_BAR; PG8_WAIT_L(0); PG8_MMA(0, 1, At, B1); PG8_BAR;
            PG8_LDA(At, 1, 1); PG8_STAGE(PG8_SA(1, 0), a3, voffA);
            PG8_BAR; PG8_WAIT_L(0); PG8_MMA(1, 0, At, B0); PG8_BAR; PG8_SCHED;
            PG8_STAGE(PG8_SB(1, 1), b3 + hstepB, voffB);
            PG8_WAIT_V(6); PG8_BAR; PG8_MMA(1, 1, At, B1); PG8_BAR;
            }
        }
        if constexpr (ALIGN_EPI) { if (wr == 0) PG8_BAR; }
        if constexpr (!Epi::AFTER_DRAIN) { E(acc, cur, wr, wc, fr, fq); S.done(cur); }
        if (!has_next) break;
#pragma unroll
        for (int a = 0; a < 2; ++a)
#pragma unroll
            for (int b = 0; b < 2; ++b)
#pragma unroll
                for (int m = 0; m < 4; ++m)
#pragma unroll
                    for (int n = 0; n < 2; ++n) acc[a][b][m][n] = (f32x4){0.f, 0.f, 0.f, 0.f};
        cur = nxt; cA = nA; cB = nB; ++ui;
        if constexpr (ALIGN_EPI) { if (wr == 1) PG8_BAR; }
    }
    PG8_WAIT_V(0);
    if constexpr (!ALIGN_EPI) { if (wr == 0) PG8_BAR; }
    PG8_BAR;
    if constexpr (Epi::AFTER_DRAIN) { E.fused(acc, cur, wr, wc, fr, fq, lds, wid, lane); S.done(cur); }
#undef PG8_SA
#undef PG8_SB
#undef PG8_STAGE
#undef PG8_LDA
#undef PG8_LDB
#undef PG8_MMA
#undef PG8_WAIT_V
#undef PG8_WAIT_L
#undef PG8_BAR
#undef PG8_SCHED
}
}
namespace fox {
constexpr int D = 128;
constexpr float SCALE = 0.08838834764831845f;
constexpr float THR = 8.f;
constexpr int NW = 8, QBLK = 32, KVBLK = 64, QB = NW * QBLK;
constexpr int SHM_V = KVBLK * D * 2, SHM_K = KVBLK * D * 2;
constexpr int LDS_BYTES = 2 * SHM_V + 2 * SHM_K + NW * 64 * 4;
typedef unsigned short bf16;
typedef short bf16x8 __attribute__((ext_vector_type(8)));
typedef short s16x4 __attribute__((ext_vector_type(4)));
typedef float f32x16 __attribute__((ext_vector_type(16)));
typedef float f32x4 __attribute__((ext_vector_type(4)));
typedef unsigned u32x4 __attribute__((ext_vector_type(4)));

#define KSWZ(row, colB) ((row) * 256 + ((colB) ^ (((row) & 7) << 4)))
#define SBAR() __builtin_amdgcn_sched_barrier(0)
__device__ __forceinline__ int v_st(int k, int c) { const int kk = (k & ~0xC) | ((k & 4) << 1) | ((k & 8) >> 1); return ((kk >> 3) * 4 + (c >> 5)) * 512 + ((kk & 7) * 32 + (c & 31)) * 2; }
__device__ __forceinline__ int v_rd_base(int lane) { return ((lane & 3) << 3) | (((lane >> 2) & 3) << 6) | (((lane >> 4) & 1) << 5) | (((lane >> 5) & 1) << 8); }
constexpr int v_rd_off(int d0, int ks, int half) { return d0 * 512 + ks * 4096 + half * 2048; }
__device__ __forceinline__ int crow(int r, int hi) { return (r & 3) + 8 * (r >> 2) + 4 * hi; }
__device__ __forceinline__ unsigned cvtpk(float lo, float hi) { unsigned r; asm volatile("v_cvt_pk_bf16_f32 %0, %1, %2" : "=v"(r) : "v"(lo), "v"(hi)); return r; }
__device__ __forceinline__ bf16x8 load8(const bf16* p) { return *reinterpret_cast<const bf16x8*>(p); }
__device__ __forceinline__ void mask_tile(f32x16& p0, f32x16& p1, int dq, unsigned W) {
    const float NEG = -__builtin_inff();
#pragma unroll
    for (int r = 0; r < 16; ++r) {
        const int c = (r & 3) + 8 * (r >> 2);
        if ((unsigned)(dq - c) >= W) p0[r] = NEG;
        if ((unsigned)(dq - c - 32) >= W) p1[r] = NEG;
    }
}
__device__ __forceinline__ void partialSM(f32x16& p0, f32x16& p1, float& m_reg, float& mn, float& alpha) {
    float pmax = p0[0]; for (int r = 1; r < 16; ++r) pmax = fmaxf(pmax, p0[r]); for (int r = 0; r < 16; ++r) pmax = fmaxf(pmax, p1[r]);
    { auto rr = __builtin_amdgcn_permlane32_swap(__float_as_uint(pmax), __float_as_uint(pmax), false, false);
      pmax = fmaxf(__uint_as_float(rr[0]), __uint_as_float(rr[1])); }
    constexpr float C2 = 1.4426950408889634f * SCALE;
    if (__builtin_expect(__all((pmax - m_reg) * SCALE <= THR), 1)) { mn = m_reg; alpha = 1.f; }
    else { mn = fmaxf(m_reg, pmax); alpha = __builtin_amdgcn_exp2f((m_reg - mn) * C2); m_reg = mn; }
    const float mnL = -mn * C2;
    for (int r = 0; r < 16; ++r) p0[r] = fmaf(p0[r], C2, mnL); for (int r = 0; r < 16; ++r) p1[r] = fmaf(p1[r], C2, mnL);
    for (int r = 0; r < 16; ++r) p0[r] = __builtin_amdgcn_exp2f(p0[r]);
}
__device__ __forceinline__ void finishSM(f32x16& p0, f32x16& p1, float alpha, float& l_reg, bf16x8& pa0, bf16x8& pa1, bf16x8& pa2, bf16x8& pa3) {
    for (int r = 0; r < 16; ++r) p1[r] = __builtin_amdgcn_exp2f(p1[r]);
    float ps = 0; for (int r = 0; r < 16; ++r) ps += p0[r]; for (int r = 0; r < 16; ++r) ps += p1[r];
    { auto rr = __builtin_amdgcn_permlane32_swap(__float_as_uint(ps), __float_as_uint(ps), false, false);
      ps = __uint_as_float(rr[0]) + __uint_as_float(rr[1]); }
    l_reg = l_reg * alpha + ps;
#define PK4(P, B_, OUT) do { unsigned a0 = cvtpk(P[B_+0], P[B_+1]), a1 = cvtpk(P[B_+2], P[B_+3]);                          \
        unsigned b0 = cvtpk(P[B_+4], P[B_+5]), b1 = cvtpk(P[B_+6], P[B_+7]);                                             \
        auto r0 = __builtin_amdgcn_permlane32_swap(a0, b0, false, false); auto r1 = __builtin_amdgcn_permlane32_swap(a1, b1, false, false); \
        u32x4 w = {r0[0], r1[0], r0[1], r1[1]}; OUT = *reinterpret_cast<bf16x8*>(&w); } while (0)
    PK4(p0, 0, pa0); PK4(p0, 8, pa1); PK4(p1, 0, pa2); PK4(p1, 8, pa3);
#undef PK4
}
template <int KB>
__device__ __forceinline__ void qkt(f32x16& p0, f32x16& p1, const char* K_lds, int r32, int hi, const bf16x8* qr, const float bias0, const float bias1) {
    p0 = f32x16{}; p1 = f32x16{};
    const char* kb[4];
#pragma unroll
    for (int dd = 0; dd < 4; ++dd) kb[dd] = K_lds + KB * SHM_K + KSWZ(r32, (dd * 16 + hi * 8) * 2);
#pragma unroll
    for (int d0 = 0; d0 < 8; ++d0) { const char* a = kb[d0 & 3] + (d0 >> 2) * 128;
        bf16x8 b0 = *reinterpret_cast<const bf16x8*>(a);
        bf16x8 b1 = *reinterpret_cast<const bf16x8*>(a + 32 * 256);
        p0 = __builtin_amdgcn_mfma_f32_32x32x16_bf16(b0, qr[d0], p0, 0, 0, 0);
        p1 = __builtin_amdgcn_mfma_f32_32x32x16_bf16(b1, qr[d0], p1, 0, 0, 0); }
    const float one = hi ? 0.f : 1.f;
    p0 = __builtin_amdgcn_mfma_f32_32x32x2f32(bias0, one, p0, 0, 0, 0);
    p1 = __builtin_amdgcn_mfma_f32_32x32x2f32(bias1, one, p1, 0, 0, 0);
}
template <int VB>
__device__ __forceinline__ void pv_tile(f32x16* o, int vb0, bf16x8 pa0, bf16x8 pa1, bf16x8 pa2, bf16x8 pa3) {
#define TRRD(dst, off) asm volatile("ds_read_b64_tr_b16 %0, %1 offset:%2" : "=&v"(dst) : "v"(vb0), "i"(off) : "memory")
#define PV_D0(d0) do { s16x4 l0, l1, l2, l3, h0, h1, h2, h3; constexpr int b_ = VB * SHM_V + v_rd_off(d0, 0, 0); \
        TRRD(l0, b_); TRRD(h0, b_ + 2048); TRRD(l1, b_ + 4096); TRRD(h1, b_ + 6144); TRRD(l2, b_ + 8192); TRRD(h2, b_ + 10240); TRRD(l3, b_ + 12288); TRRD(h3, b_ + 14336); \
        asm volatile("s_waitcnt lgkmcnt(0)" ::: "memory"); SBAR();   \
        o[d0] = __builtin_amdgcn_mfma_f32_32x32x16_bf16(pa0, (bf16x8){l0[0], l0[1], l0[2], l0[3], h0[0], h0[1], h0[2], h0[3]}, o[d0], 0, 0, 0);   \
        o[d0] = __builtin_amdgcn_mfma_f32_32x32x16_bf16(pa1, (bf16x8){l1[0], l1[1], l1[2], l1[3], h1[0], h1[1], h1[2], h1[3]}, o[d0], 0, 0, 0);   \
        o[d0] = __builtin_amdgcn_mfma_f32_32x32x16_bf16(pa2, (bf16x8){l2[0], l2[1], l2[2], l2[3], h2[0], h2[1], h2[2], h2[3]}, o[d0], 0, 0, 0);   \
        o[d0] = __builtin_amdgcn_mfma_f32_32x32x16_bf16(pa3, (bf16x8){l3[0], l3[1], l3[2], l3[3], h3[0], h3[1], h3[2], h3[3]}, o[d0], 0, 0, 0); } while (0)
    PV_D0(0); PV_D0(1); PV_D0(2); PV_D0(3);
#undef PV_D0
#undef TRRD
}
typedef float f32x2 __attribute__((ext_vector_type(2)));
struct BlockRef { const bf16* Q; const bf16* K; const bf16* V; bf16* O; const f32x2* CB; int P0; };
struct Seam { bf16x8 qr[8]; bf16x8 st_v0, st_v1, st_k0, st_k1; };
template <int LDQ, int LDO> struct Body {
#define ROW(p, k0, rr) ((p) + (unsigned)(((k0) + (rr)) * LDQ + sc))
#define VMW() asm volatile("s_waitcnt vmcnt(0)" ::: "memory")
#define VMWN(n) asm volatile("s_waitcnt vmcnt(%0)" :: "i"(n) : "memory")
#define SLOAD_H(Kp, Vp, k0) do { S.st_v0 = load8(ROW(Vp, k0, sr)); S.st_v1 = load8(ROW(Vp, k0, 32 + sr));              \
                         S.st_k0 = load8(ROW(Kp, k0, sr)); S.st_k1 = load8(ROW(Kp, k0, 32 + sr)); } while (0)
#define SWRITE_HK(bf) do { *(bf16x8*)(K_lds + (bf) * SHM_K + kws) = S.st_k0; *(bf16x8*)(K_lds + (bf) * SHM_K + kws + 32 * 256) = S.st_k1; } while (0)
#define SWRITE_HV(bf) do { *(bf16x8*)(V_lds + (bf) * SHM_V + vst0) = S.st_v0; *(bf16x8*)(V_lds + (bf) * SHM_V + vst1) = S.st_v1; } while (0)
#define SWRITE_H(bf) do { SWRITE_HV(bf); SWRITE_HK(bf); } while (0)
    static __device__ __forceinline__ void prime(const BlockRef& cur, char* lds, Seam& S) {
        const int tid = threadIdx.x, wid = __builtin_amdgcn_readfirstlane(tid >> 6), lane = tid & 63, r32 = lane & 31, hi = lane >> 5;
        const int sr = tid >> 4, sc = (tid & 15) * 8, kws = KSWZ(sr, sc * 2); char* K_lds = lds + 2 * SHM_V;
        const int kb0 = 0;
        for (int d0 = 0; d0 < 8; ++d0) S.qr[d0] = load8(cur.Q + (unsigned)((wid * QBLK + r32) * LDQ + d0 * 16 + hi * 8));
        SLOAD_H(cur.K, cur.V, kb0); VMW(); SWRITE_HK(0);
        __syncthreads();
    }
    static __device__ __forceinline__ void block(const BlockRef& cur, const BlockRef& nxt, int skv, char* lds, Seam& S) {
        const int tid = threadIdx.x, wid = __builtin_amdgcn_readfirstlane(tid >> 6), lane = tid & 63, r32 = lane & 31, hi = lane >> 5;
        const int W = skv;
        const int j_lo = 0;
        int j_hi = (cur.P0 + QB - 1) / KVBLK + 1; if (j_hi > skv / KVBLK) j_hi = skv / KVBLK;
        const int NT = j_hi - j_lo;
        const int kbn = 0;
        const int qlo = cur.P0 + wid * QBLK, qm = qlo + r32 - 4 * hi;
        char* V_lds = lds; char* K_lds = lds + 2 * SHM_V;
        float* ws = (float*)(lds + 2 * SHM_V + 2 * SHM_K) + wid * 64; float* li_l = ws, * al_l = ws + 32;
        float m_reg = -1e30f, l_reg = 0; f32x16 o[4] = {};
        const int sr = tid >> 4, sc = (tid & 15) * 8, vst0 = v_st(sr, sc), vst1 = v_st(32 + sr, sc), kws = KSWZ(sr, sc * 2);
        const int vb0 = (int)(uintptr_t)V_lds + v_rd_base(lane);
        const bf16* Kh = cur.K; const bf16* Vh = cur.V;
        const char* cbb = (const char*)cur.CB; const unsigned cbo = (unsigned)r32 * 8u;
        f32x2 bw = *(const f32x2*)(cbb + cbo);
#define BLOAD(t) do { bw = *(const f32x2*)(cbb + (cbo + (unsigned)((t) * 256))); } while (0)
#define RESC(a) do { if (__any((a) < 1.f)) { if (hi == 0) al_l[r32] = (a); asm volatile("s_waitcnt lgkmcnt(0)" ::: "memory");              \
                     for (int d_ = 0; d_ < 4; ++d_) for (int r = 0; r < 16; ++r) o[d_][r] *= al_l[crow(r, hi)]; } } while (0)
#define KBASE(t) ((j_lo + (t)) * KVBLK)
#define MASKT(P0_, P1_, t) do { const int kb_ = KBASE(t); if (kb_ + KVBLK - 1 > qlo || kb_ <= qlo + QBLK - 1 - W) mask_tile(P0_, P1_, qm - kb_, (unsigned)W); } while (0)
        constexpr int NQL = 8;
#define SEAM_K0() do { VMWN(NQL); SWRITE_HK(0); SBAR(); } while (0)
        f32x16 pA0, pA1, pB0, pB1; float mnA, mnB, alA, alB; bf16x8 pa0, pa1, pa2, pa3;
        SWRITE_HV(0); SBAR();
        if (NT > 1) { SLOAD_H(Kh, Vh, KBASE(1)); }
        SBAR(); qkt<0>(pA0, pA1, K_lds, r32, hi, S.qr, bw.x, bw.y); if (NT > 1) BLOAD(1);
        MASKT(pA0, pA1, 0); partialSM(pA0, pA1, m_reg, mnA, alA);
        if (NT > 1) { VMW(); SWRITE_H(1); }
        __syncthreads();
#define HALF_STEP(PX0, PX1, mnX, alX, PY0, PY1, alY, t, KB, VB, SB) do {                                                      \
        SBAR(); qkt<KB>(PX0, PX1, K_lds, r32, hi, S.qr, bw.x, bw.y); if ((t) + 1 < NT) BLOAD((t) + 1);                   \
        finishSM(PY0, PY1, alY, l_reg, pa0, pa1, pa2, pa3); SBAR();                                                           \
        if ((t) + 1 < NT) { SLOAD_H(Kh, Vh, KBASE((t) + 1)); SBAR(); }                                                       \
        pv_tile<VB>(o, vb0, pa0, pa1, pa2, pa3); MASKT(PX0, PX1, (t)); partialSM(PX0, PX1, m_reg, mnX, alX);                    \
        __syncthreads();                                                                                                      \
        if ((t) + 1 < NT) { VMW(); SWRITE_H(SB); }                                                                            \
        RESC(alX); __syncthreads(); } while (0)
        for (int t = 1; t + 1 < NT; t += 2) {
            HALF_STEP(pB0, pB1, mnB, alB, pA0, pA1, alA, t, 1, 0, 0);
            HALF_STEP(pA0, pA1, mnA, alA, pB0, pB1, alB, t + 1, 0, 1, 1);
        }
        const bool even = (NT & 1) == 0;
        if (even) { SBAR(); qkt<1>(pB0, pB1, K_lds, r32, hi, S.qr, bw.x, bw.y); SBAR(); }
        SLOAD_H(nxt.K, nxt.V, kbn); SBAR();
#pragma unroll
        for (int d0 = 0; d0 < 8; ++d0) S.qr[d0] = load8(nxt.Q + (unsigned)((wid * QBLK + r32) * LDQ + d0 * 16 + hi * 8));
        SBAR();
        finishSM(pA0, pA1, alA, l_reg, pa0, pa1, pa2, pa3); SBAR();
        pv_tile<0>(o, vb0, pa0, pa1, pa2, pa3);
        if (even) { MASKT(pB0, pB1, NT - 1); partialSM(pB0, pB1, m_reg, mnB, alB); __syncthreads(); RESC(alB);
            finishSM(pB0, pB1, alB, l_reg, pa0, pa1, pa2, pa3); SBAR(); pv_tile<1>(o, vb0, pa0, pa1, pa2, pa3); }
        SBAR(); SEAM_K0();
        if (hi == 0) li_l[r32] = l_reg; asm volatile("s_waitcnt lgkmcnt(0)" ::: "memory");
        float rli[16];
#pragma unroll
        for (int r = 0; r < 16; ++r) rli[r] = __builtin_amdgcn_rcpf(li_l[crow(r, hi)]);
        bf16* Ow = cur.O + (unsigned)((wid * QBLK) * LDO);
#pragma unroll
        for (int r = 0; r < 16; ++r) { const int orow = crow(r, hi);
#pragma unroll
            for (int d0 = 0; d0 < 4; ++d0) { const float v = o[d0][r] * rli[r];
                const float vn = __shfl_xor(v, 1);
                if ((r32 & 1) == 0) *(unsigned*)(Ow + (unsigned)(orow * LDO + d0 * 32 + r32)) = cvtpk(v, vn); } }
        __syncthreads();
#undef RESC
#undef KBASE
#undef MASKT
#undef SEAM_K0
#undef HALF_STEP
#undef BLOAD
    }
#undef ROW
#undef VMW
#undef VMWN
#undef SLOAD_H
#undef SWRITE_HK
#undef SWRITE_HV
#undef SWRITE_H
};
#undef KSWZ
#undef SBAR
}

constexpr int NWAVES = 8;
constexpr int DM = 4096, BATCH = 4, SEQ = 4096, M = BATCH * SEQ;
constexpr int NH = 16, HD = 128, HW = NH * HD;
constexpr int DFF = 11008, N_IN = 22576, CONVW = 3 * HW;
constexpr int LDP = 22528;
constexpr int PC_QA = 0, PC_KA = 2048, PC_VA = 4096, PC_ZA = 6144, PC_QB = 8192, PC_KB = 10240, PC_VB = 12288, PC_GA = 14336, PC_GB = 18432;
constexpr int SC_BETA = 8192, SC_ALPHA = 8208, SC_QB = 8224, SC_F = 14368, SC_GA = 14384;
constexpr int NSM = 48;
constexpr float EPS = 1e-6f;

constexpr size_t MiB = 1u << 20;
constexpr size_t WS_CTL = 0, CTL_ZERO_BYTES = 1 * MiB;
constexpr size_t WS_WIN = 1 * MiB;
constexpr size_t WS_WSM = 177 * MiB;
constexpr size_t WS_WA = 178 * MiB;
constexpr size_t WS_WB = 194 * MiB;
constexpr size_t WS_WO = 210 * MiB;
constexpr size_t WS_WGU = 242 * MiB;
constexpr size_t WS_WD = 414 * MiB;
constexpr size_t WS_XN = 500 * MiB;
constexpr size_t WS_OA = WS_XN, WS_OB = WS_XN + 64 * MiB;
constexpr size_t WS_SMALL = 628 * MiB;
constexpr size_t WS_CB = 631 * MiB;
constexpr size_t WS_P = 634 * MiB;
constexpr size_t WS_HN = WS_P, WS_ACT = WS_P + 128 * MiB;
constexpr size_t WS_MG = WS_WIN;
constexpr size_t WS_END = 1338 * MiB;
constexpr size_t WS_UF = WS_WIN;
constexpr size_t WS_EG = 512 * 1024;
constexpr int CW_BAR = 4096;
constexpr int CW_QUEUE = 8192;

constexpr int RING_OFF = 0, RING_BYTES = 155648;
constexpr int LDSCTL_OFF = RING_BYTES, MISC_OFF = LDSCTL_OFF + 320;
constexpr int LDS_BYTES = 157696;

#define GAS __attribute__((address_space(1)))
#define LAS __attribute__((address_space(3)))
typedef unsigned short bf16;
typedef unsigned v4u __attribute__((ext_vector_type(4)));
typedef unsigned v2u __attribute__((ext_vector_type(2)));
typedef float f32x4 __attribute__((ext_vector_type(4)));
typedef short bf16x8 __attribute__((ext_vector_type(8)));
#define LDS_WAIT() asm volatile("s_waitcnt lgkmcnt(0)" ::: "memory")
#define VM_WAIT() asm volatile("s_waitcnt vmcnt(0)" ::: "memory")
typedef float f32x2c __attribute__((ext_vector_type(2)));
typedef __bf16 bf16x2c __attribute__((ext_vector_type(2)));
__device__ __forceinline__ unsigned pk2(float lo, float hi) { const f32x2c v = {lo, hi}; return __builtin_bit_cast(unsigned, __builtin_convertvector(v, bf16x2c)); }
__device__ __forceinline__ unsigned f2bf(float f) { return pk2(f, f) & 0xffffu; }
__device__ __forceinline__ float bflo(unsigned w) { return __uint_as_float(w << 16); }
__device__ __forceinline__ float bfhi(unsigned w) { return __uint_as_float(w & 0xffff0000u); }
__device__ __forceinline__ float wave_sum(float v) {
#pragma unroll
    for (int o = 1; o < 64; o <<= 1) v += __shfl_xor(v, o);
    return v;
}
template <int CTRL> __device__ __forceinline__ float dppmov(float v) { return __builtin_bit_cast(float, __builtin_amdgcn_update_dpp(0, __builtin_bit_cast(int, v), CTRL, 0xF, 0xF, true)); }
__device__ __forceinline__ float sum8(float v) { v += dppmov<0xB1>(v); v += dppmov<0x4E>(v); v += dppmov<0x141>(v); return v; }
__device__ __forceinline__ float sum16(float v) { v = sum8(v); v += dppmov<0x140>(v); return v; }
__device__ __forceinline__ float silu_f(float x) { return x / (1.0f + __expf(-x)); }
__device__ __forceinline__ float silu_fast(float x) { return x * __builtin_amdgcn_rcpf(1.0f + __builtin_amdgcn_exp2f(-1.4426950408889634f * x)); }
__device__ __forceinline__ float sigm_f(float x) { return 1.0f / (1.0f + __expf(-x)); }
__device__ __forceinline__ float softplus_f(float x) { return fmaxf(x, 0.f) + log1pf(__expf(-fabsf(x))); }

#define XB_TMO      128
#define XB_XCNT(j)  (256  + 64 * (j))
#define XB_XSUB(j)  (1280 + 64 * (j))
#define XB_XGEN(j)  (2304 + 64 * (j))
#define XB_TOP      3328
#define XB_TOPGEN   3392
#define XCD_BAR_WORDS 3456
#define XB_SPIN_CAP (1u << 18)
__device__ __forceinline__ unsigned xb_ld(unsigned* p)              { return __hip_atomic_load(p, __ATOMIC_RELAXED, __HIP_MEMORY_SCOPE_AGENT); }
__device__ __forceinline__ unsigned xb_add(unsigned* p, unsigned v) { return __hip_atomic_fetch_add(p, v, __ATOMIC_RELAXED, __HIP_MEMORY_SCOPE_AGENT); }
__device__ __forceinline__ unsigned xb_xcc_id() { return (unsigned)__builtin_amdgcn_s_getreg((3 << 11) | 20) & 0xFu; }
#define XB_SPIN(cond, bar) do { unsigned _sp = 0; while (cond) { __builtin_amdgcn_s_sleep(1); \
    if ((++_sp & 255u) == 0u) { if (xb_ld(&(bar)[XB_TMO])) break; if (_sp > XB_SPIN_CAP) { atomicAdd(&(bar)[XB_TMO], 1u); break; } } } } while (0)
struct XcdBarrier { unsigned* bar; unsigned x; volatile LAS unsigned* st; };
__device__ __forceinline__ XcdBarrier xcd_barrier_post(unsigned* bar, volatile LAS unsigned* st) {
    XcdBarrier b; b.bar = bar; b.x = xb_xcc_id(); b.st = st;
    if (threadIdx.x == 0) (void)xb_add(&bar[XB_XCNT(b.x)], 1u);
    return b;
}
__device__ __forceinline__ void xcd_barrier_complete(unsigned* bar, unsigned x, unsigned& nloc, unsigned& nx) {
    const unsigned G = gridDim.x * gridDim.y * gridDim.z;
    unsigned sum, cnt, mine, sp = 0u;
    for (;;) {
        sum = 0u; cnt = 0u; mine = 0u;
#pragma unroll
        for (unsigned j = 0; j < 16; ++j) { const unsigned c = xb_ld(&bar[XB_XCNT(j)]); sum += c; cnt += (c > 0u) ? 1u : 0u; mine = (j == x) ? c : mine; }
        if (sum == G) break;
        __builtin_amdgcn_s_sleep(1);
        if ((++sp & 255u) == 0u) { if (xb_ld(&bar[XB_TMO])) break; if (sp > XB_SPIN_CAP) { atomicAdd(&bar[XB_TMO], 1u); break; } }
    }
    nloc = mine > 0u ? mine : 1u; nx = cnt > 0u ? cnt : 1u;
}
__device__ __forceinline__ void xcd_barrier(const XcdBarrier& b) {
    asm volatile("s_waitcnt vmcnt(0)" ::: "memory");
    __syncthreads();
    if (threadIdx.x == 0) {
        unsigned* bar = b.bar;
        __builtin_amdgcn_s_waitcnt(0);
        unsigned nloc = b.st[0], nx = b.st[1];
        if (nloc == 0u) { xcd_barrier_complete(bar, b.x, nloc, nx); b.st[0] = nloc; b.st[1] = nx; }
        const unsigned old = xb_add(&bar[XB_XSUB(b.x)], 1u);
        const unsigned gen = old / nloc;
        if (old + 1u == (gen + 1u) * nloc) {
            __builtin_amdgcn_fence(__ATOMIC_RELEASE, "agent");
            asm volatile("s_waitcnt vmcnt(0)" ::: "memory");
            const unsigned og = xb_add(&bar[XB_TOP], 1u);
            const unsigned tg = og / nx;
            if (og + 1u == (tg + 1u) * nx) xb_add(&bar[XB_TOPGEN], 1u);
            else XB_SPIN(xb_ld(&bar[XB_TOPGEN]) == tg, bar);
            __builtin_amdgcn_fence(__ATOMIC_ACQUIRE, "agent");
            xb_add(&bar[XB_XGEN(b.x)], 1u);
            asm volatile("s_waitcnt vmcnt(0)" ::: "memory");
        } else {
            XB_SPIN(xb_ld(&bar[XB_XGEN(b.x)]) == gen, bar);
            __builtin_amdgcn_fence(__ATOMIC_ACQUIRE, "agent");
            asm volatile("s_waitcnt vmcnt(0)" ::: "memory");
        }
    }
    __syncthreads();
}

__device__ __forceinline__ size_t wimg_off(int row, int K, int k0) { return pg8::WIMG ? ((size_t)(row >> 8) * (K >> 6) + (k0 >> 6)) * (256 * 64) + (size_t)(row & 255) * 64 : (size_t)row * K + k0; }
__device__ __forceinline__ void transpose_items(const float* W, int K, int ldw, int src0, int ncols, int blk, int mul, int add, bf16* WT, LAS float* scr, int gw, int NGW, int lane) {
    const int nblk = ncols / 32, nitems = (K / 64) * nblk;
    for (int it = gw; it < nitems; it += NGW) {
        const int kb = it / nblk, nb = it - kb * nblk, k0 = 64 * kb, nl = 32 * nb;
        const int drow = (nl / blk) * mul + (nl % blk) + add;
        const float* src = W + (size_t)k0 * ldw + src0 + nl + (lane & 31);
        float tv[32];
#pragma unroll
        for (int i = 0; i < 32; ++i) tv[i] = src[(size_t)(2 * i + (lane >> 5)) * ldw];
#pragma unroll
        for (int i = 0; i < 32; ++i) scr[(2 * i + (lane >> 5)) * 33 + (lane & 31)] = tv[i];
        LDS_WAIT(); asm volatile("" ::: "memory");
        const int c = lane & 7;
#pragma unroll
        for (int j = 0; j < 4; ++j) { const int n = (lane >> 3) + 8 * j; const LAS float* s = scr + (8 * c) * 33 + n;
            v4u o; o.x = pk2(s[0 * 33], s[1 * 33]); o.y = pk2(s[2 * 33], s[3 * 33]); o.z = pk2(s[4 * 33], s[5 * 33]); o.w = pk2(s[6 * 33], s[7 * 33]);
            *(v4u*)(WT + wimg_off(drow + n, K, k0) + 8 * c) = o; }
        LDS_WAIT(); asm volatile("" ::: "memory");
    }
}
__device__ __forceinline__ void transpose_items_pipe(const float* W, int K, int ldw, int src0, int ncols, int blk, int mul, int add, bf16* WT, LAS float* scr, int gw, int NGW, int lane) {
    const int nblk = ncols / 32, nitems = (K / 64) * nblk;
    int it = gw; if (it >= nitems) return;
    float tv[32];
    { const int kb = it / nblk, nb = it - kb * nblk; const float* src = W + (size_t)(64 * kb) * ldw + src0 + 32 * nb + (lane & 31);
#pragma unroll
      for (int i = 0; i < 32; ++i) tv[i] = src[(size_t)(2 * i + (lane >> 5)) * ldw]; }
    for (;;) {
        const int kb = it / nblk, nb = it - kb * nblk, k0 = 64 * kb, nl = 32 * nb;
        const int drow = (nl / blk) * mul + (nl % blk) + add;
        const int nit = it + NGW; const bool more = nit < nitems;
        float nv[32];
        { const int ld = more ? nit : it;
          const int kb2 = ld / nblk, nb2 = ld - kb2 * nblk; const float* src = W + (size_t)(64 * kb2) * ldw + src0 + 32 * nb2 + (lane & 31);
#pragma unroll
          for (int i = 0; i < 32; ++i) nv[i] = src[(size_t)(2 * i + (lane >> 5)) * ldw]; }
        asm volatile("" ::: "memory");
#pragma unroll
        for (int i = 0; i < 32; ++i) scr[(2 * i + (lane >> 5)) * 33 + (lane & 31)] = tv[i];
        LDS_WAIT(); asm volatile("" ::: "memory");
        const int c = lane & 7;
#pragma unroll
        for (int j = 0; j < 4; ++j) { const int n = (lane >> 3) + 8 * j; const LAS float* s = scr + (8 * c) * 33 + n;
            v4u o; o.x = pk2(s[0 * 33], s[1 * 33]); o.y = pk2(s[2 * 33], s[3 * 33]); o.z = pk2(s[4 * 33], s[5 * 33]); o.w = pk2(s[6 * 33], s[7 * 33]);
            *(v4u*)(WT + wimg_off(drow + n, K, k0) + 8 * c) = o; }
        LDS_WAIT(); asm volatile("" ::: "memory");
        if (!more) break;
#pragma unroll
        for (int i = 0; i < 32; ++i) tv[i] = nv[i];
        it = nit;
    }
}
__device__ __forceinline__ void rms_row_to_bf16(const float* __restrict__ xrow, const float* __restrict__ w, bf16* __restrict__ orow, int lane) {
    const f32x4* xr = (const f32x4*)xrow + lane; const f32x4* wr = (const f32x4*)w + lane;
    f32x4 v[16], g[16]; float s = 0.f;
#pragma unroll
    for (int j = 0; j < 16; ++j) { v[j] = xr[64 * j]; g[j] = wr[64 * j]; }
#pragma unroll
    for (int j = 0; j < 16; ++j) s += (v[j].x * v[j].x + v[j].y * v[j].y) + (v[j].z * v[j].z + v[j].w * v[j].w);
    const float rstd = 1.0f / sqrtf(wave_sum(s) * (1.0f / DM) + EPS);
    unsigned long long* o8 = (unsigned long long*)orow + lane;
#pragma unroll
    for (int j = 0; j < 16; ++j)
        o8[64 * j] = (unsigned long long)pk2(v[j].x * rstd * g[j].x, v[j].y * rstd * g[j].y) | ((unsigned long long)pk2(v[j].z * rstd * g[j].z, v[j].w * rstd * g[j].w) << 32);
}
__device__ __forceinline__ void rms_row_bf16_to_bf16(const bf16* __restrict__ xrow, const float* __restrict__ w, bf16* __restrict__ orow, int lane) {
    const v4u* xr = (const v4u*)xrow + lane; const f32x4* wr = (const f32x4*)w + 2 * lane;
    v4u xv[8]; f32x4 g[16]; float s = 0.f;
#pragma unroll
    for (int j = 0; j < 8; ++j) { xv[j] = xr[64 * j]; g[2 * j] = wr[128 * j]; g[2 * j + 1] = wr[128 * j + 1]; }
    float v[64];
#pragma unroll
    for (int j = 0; j < 8; ++j) { v[8 * j] = bflo(xv[j].x); v[8 * j + 1] = bfhi(xv[j].x); v[8 * j + 2] = bflo(xv[j].y); v[8 * j + 3] = bfhi(xv[j].y);
        v[8 * j + 4] = bflo(xv[j].z); v[8 * j + 5] = bfhi(xv[j].z); v[8 * j + 6] = bflo(xv[j].w); v[8 * j + 7] = bfhi(xv[j].w); }
#pragma unroll
    for (int i = 0; i < 64; ++i) s += v[i] * v[i];
    const float rstd = 1.0f / sqrtf(wave_sum(s) * (1.0f / DM) + EPS);
    v4u* o = (v4u*)orow + lane;
#pragma unroll
    for (int j = 0; j < 8; ++j) { const f32x4 g0 = g[2 * j], g1 = g[2 * j + 1]; v4u ow;
        ow.x = pk2(v[8 * j] * rstd * g0.x, v[8 * j + 1] * rstd * g0.y); ow.y = pk2(v[8 * j + 2] * rstd * g0.z, v[8 * j + 3] * rstd * g0.w);
        ow.z = pk2(v[8 * j + 4] * rstd * g1.x, v[8 * j + 5] * rstd * g1.y); ow.w = pk2(v[8 * j + 6] * rstd * g1.z, v[8 * j + 7] * rstd * g1.w);
        o[64 * j] = ow; }
}
__device__ __forceinline__ void small_gemm(const bf16* XN, const bf16* WS, float* OUT, int gw, int NGW, int lane, int one_task = -1) {
    for (int task = (one_task >= 0 ? one_task : gw); task < M / 16; task += (one_task >= 0 ? M : NGW)) {
        const int m0 = task * 16;
        f32x4 acc[3] = {{0.f, 0.f, 0.f, 0.f}, {0.f, 0.f, 0.f, 0.f}, {0.f, 0.f, 0.f, 0.f}};
        const bf16* ap = XN + (size_t)(m0 + (lane & 15)) * DM + (lane >> 4) * 8;
        const bf16* bp = WS + (size_t)(lane & 15) * DM + (lane >> 4) * 8;
#pragma unroll 4
        for (int kt = 0; kt < DM / 32; ++kt) {
            const bf16x8 a = *(const bf16x8*)(ap + kt * 32);
#pragma unroll
            for (int nb = 0; nb < 3; ++nb) { const bf16x8 b = *(const bf16x8*)(bp + (size_t)nb * 16 * DM + kt * 32);
                acc[nb] = __builtin_amdgcn_mfma_f32_16x16x32_bf16(a, b, acc[nb], 0, 0, 0); }
        }
#pragma unroll
        for (int nb = 0; nb < 3; ++nb)
            *(f32x4*)(OUT + (size_t)(nb * 16 + (lane & 15)) * M + m0 + (lane >> 4) * 4) = acc[nb];
    }
}
__device__ __forceinline__ void fox_cumsum_wg(const float* SMALL, const float* b_f, unsigned* CB, int bh, LAS float* red) {
    const int tid = threadIdx.x, lane = tid & 63, wave = tid >> 6;
    const int b = bh / NH, h = bh % NH; const float bf = b_f[h];
    const f32x4* src = (const f32x4*)(SMALL + (size_t)(32 + h) * M + (size_t)b * SEQ + (size_t)tid * 8);
    const f32x4 v0 = src[0], v1 = src[1];
    float ls[8] = {v0.x, v0.y, v0.z, v0.w, v1.x, v1.y, v1.z, v1.w};
    float tot = 0.f;
#pragma unroll
    for (int i = 0; i < 8; ++i) { const float x = ls[i] + bf;
        tot += fminf(x, 0.f) - 0.6931471805599453f * __builtin_amdgcn_logf(1.0f + __builtin_amdgcn_exp2f(-1.4426950408889634f * fabsf(x))); ls[i] = tot; }
    float incl = tot;
#pragma unroll
    for (int o = 1; o < 64; o <<= 1) { const float t = __shfl_up(incl, o); if (lane >= o) incl += t; }
    if (lane == 63) red[wave] = incl;
    __syncthreads();
    float base = incl - tot;
#pragma unroll
    for (int w = 0; w < 7; ++w) base += (w < wave) ? red[w] : 0.f;
    float* dst = (float*)CB + ((size_t)bh * 64 + (tid >> 3)) * 32 * 2;
    const int p = (tid & 7) * 8;
#pragma unroll
    for (int i = 0; i < 8; ++i) dst[((p + i) & 31) * 2 + ((p + i) >> 5)] = -(base + ls[i]) * 11.313708498984761f;
}

constexpr int GREC = 57344;
constexpr int GR_W = 0, GR_Q = 16384, GR_K = 32768, GR_QK = 49152;
constexpr int RAWP = 784;
constexpr int G1_KB = 0, G1_QB = 17408, G1_RT = 34816, G1_AM = 71680, G1_SC = 89088, G1_RAW = 90112, G1_QKS = 143360;
#define GBAR() do { asm volatile("s_waitcnt lgkmcnt(0)" ::: "memory"); __builtin_amdgcn_s_barrier(); asm volatile("" ::: "memory"); } while (0)
__device__ __forceinline__ void g1_raw_offsets(unsigned (&roff)[7], int wave, int lane) {
#pragma unroll
    for (int i = 0; i < 7; ++i) { const int inst = i * 8 + wave; const int L = inst * 1024 + lane * 16; int row = L / RAWP; const int within = L - row * RAWP; if (row > 66) row = 66;
        int ten = within >> 8; const int chb = within & 255; if (ten > 2) ten = 2;
        roff[i] = (unsigned)(row * (LDP * 2) + ten * (HW * 2) + chb); }
}
__device__ __forceinline__ void g1_issue_raw(const char* base, const unsigned (&roff)[7], LAS unsigned char* raw, int wave) {
#pragma unroll
    for (int i = 0; i < 7; ++i) { const int inst = i * 8 + wave;
        if (inst < 52) __builtin_amdgcn_global_load_lds((const unsigned*)(base + roff[i]), (LAS unsigned*)(raw + inst * 1024), 16, 0, 0); }
}
__device__ __forceinline__ void gdn_prep_wg(const bf16* P, const float* SMALL, const float* conv_w, const float* a_log, const float* dt_bias,
                                            unsigned char* REC, bf16* UF, float* EG, LAS unsigned char* lds, int bh, int n0, int nch) {
    const int tid = threadIdx.x, lane = tid & 63, wave = __builtin_amdgcn_readfirstlane(tid >> 6);
    const int b = bh / NH, h = bh % NH;
    LAS unsigned char* kb = lds + G1_KB;
    LAS unsigned char* qb = lds + G1_QB;
    LAS unsigned char* RT = lds + G1_RT;
    LAS float* Amat = (LAS float*)(lds + G1_AM);
    LAS float* sc = (LAS float*)(lds + G1_SC);
    LAS unsigned char* raw = lds + G1_RAW;
    LAS unsigned char* QKs = lds + G1_QKS;
    LAS unsigned char* Tb = kb;
    LAS unsigned char* Ws = qb;
    const float Aexp = __expf(a_log[h]), dtb = dt_bias[h];
    float lg_b = 0.f, lg_a = 0.f;
    unsigned roff[7]; g1_raw_offsets(roff, wave, lane);
    const char* rbase = (const char*)P + (((size_t)b * SEQ + (size_t)n0 * 64) * LDP + h * HD) * 2 - (size_t)3 * LDP * 2;
    g1_issue_raw(rbase, roff, raw, wave);
    if (wave == 0) { const float* sm = SMALL + (size_t)b * SEQ + (size_t)n0 * 64 + lane; lg_b = sm[(size_t)h * M]; lg_a = sm[(size_t)(16 + h) * M]; }
    for (int k = 0; k < nch; ++k) {
        const int n = n0 + k, ci = bh * 64 + n;
        unsigned char* rec = REC + (size_t)ci * GREC;
        if (wave == 0) {
            const float be = sigm_f(lg_b);
            const float g = -Aexp * softplus_f(lg_a + dtb);
            float gc = g;
#pragma unroll
            for (int o = 1; o < 64; o <<= 1) { const float t = __shfl_up(gc, o); if (lane >= o) gc += t; }
            const float gl = __shfl(gc, 63);
            sc[lane] = gc; sc[64 + lane] = be; sc[128 + lane] = __expf(gc); sc[192 + lane] = __expf(gl - gc);
            if (lane == 63) EG[ci] = __expf(gl);
        }
        asm volatile("s_waitcnt vmcnt(0)" ::: "memory");
        GBAR();
        if (wave == 0 && k + 1 < nch) { const float* sm = SMALL + (size_t)b * SEQ + (size_t)(n + 1) * 64 + lane; lg_b = sm[(size_t)h * M]; lg_a = sm[(size_t)(16 + h) * M]; }
        {
            const int row = tid >> 3, cg = tid & 7, c0 = cg * 16;
            const int t = n * 64 + row;
            const float be = sc[64 + row], egc = sc[128 + row], egl = sc[192 + row];
#pragma unroll
            for (int ten = 0; ten < 3; ++ten) {
                const int pcol = ten * HW + h * HD + c0;
                float acc[16];
#pragma unroll
                for (int j = 0; j < 16; ++j) acc[j] = 0.f;
#pragma unroll
                for (int i = 0; i < 4; ++i) {
                    if (t - 3 + i >= 0) { const LAS unsigned char* src = raw + (row + i) * RAWP + ten * 256 + c0 * 2; const v4u x0 = *(const LAS v4u*)src, x1 = *(const LAS v4u*)(src + 16);
                        const float* w = conv_w + (size_t)i * CONVW + pcol;
                        const f32x4 w0 = *(const f32x4*)w, w1 = *(const f32x4*)(w + 4), w2 = *(const f32x4*)(w + 8), w3 = *(const f32x4*)(w + 12);
                        acc[0] += w0.x * bflo(x0.x); acc[1] += w0.y * bfhi(x0.x); acc[2] += w0.z * bflo(x0.y); acc[3] += w0.w * bfhi(x0.y);
                        acc[4] += w1.x * bflo(x0.z); acc[5] += w1.y * bfhi(x0.z); acc[6] += w1.z * bflo(x0.w); acc[7] += w1.w * bfhi(x0.w);
                        acc[8] += w2.x * bflo(x1.x); acc[9] += w2.y * bfhi(x1.x); acc[10] += w2.z * bflo(x1.y); acc[11] += w2.w * bfhi(x1.y);
                        acc[12] += w3.x * bflo(x1.z); acc[13] += w3.y * bfhi(x1.z); acc[14] += w3.z * bflo(x1.w); acc[15] += w3.w * bfhi(x1.w); } }
                float ss = 0.f;
#pragma unroll
                for (int j = 0; j < 16; ++j) { acc[j] = silu_fast(acc[j]); ss += acc[j] * acc[j]; }
                if (ten < 2) { ss = sum8(ss); const float s_ = (1.0f / sqrtf(ss + EPS)) * (ten == 0 ? 0.08838834764831845f : 1.0f);
#pragma unroll
                    for (int j = 0; j < 16; ++j) acc[j] *= s_; }
                if (ten == 0) {
                    v4u o0, o1; o0.x = pk2(acc[0], acc[1]); o0.y = pk2(acc[2], acc[3]); o0.z = pk2(acc[4], acc[5]); o0.w = pk2(acc[6], acc[7]);
                    o1.x = pk2(acc[8], acc[9]); o1.y = pk2(acc[10], acc[11]); o1.z = pk2(acc[12], acc[13]); o1.w = pk2(acc[14], acc[15]);
                    *(LAS v4u*)(qb + row * 272 + c0 * 2) = o0; *(LAS v4u*)(qb + row * 272 + c0 * 2 + 16) = o1;
                    unsigned char* dst = rec + GR_Q + ((row >> 4) * 4 + (c0 >> 5)) * 1024 + ((c0 >> 4) & 1) * 8;
#pragma unroll
                    for (int i = 0; i < 4; ++i) { v2u w; w.x = pk2(acc[4 * i] * egc, acc[4 * i + 1] * egc); w.y = pk2(acc[4 * i + 2] * egc, acc[4 * i + 3] * egc);
                        *(v2u*)(dst + ((row & 15) + 16 * i) * 16) = w; }
                } else if (ten == 1) {
                    v4u o0, o1; o0.x = pk2(acc[0], acc[1]); o0.y = pk2(acc[2], acc[3]); o0.z = pk2(acc[4], acc[5]); o0.w = pk2(acc[6], acc[7]);
                    o1.x = pk2(acc[8], acc[9]); o1.y = pk2(acc[10], acc[11]); o1.z = pk2(acc[12], acc[13]); o1.w = pk2(acc[14], acc[15]);
                    *(LAS v4u*)(kb + row * 272 + c0 * 2) = o0; *(LAS v4u*)(kb + row * 272 + c0 * 2 + 16) = o1;
                    const float bg = be * egc; const int off = row & 31, kq = (off & 15) >> 2, kj = (off & 3) + 4 * (off >> 4);
                    unsigned char* dst = rec + GR_K + ((c0 >> 4) * 2 + (row >> 5)) * 1024 + (16 * kq) * 16 + kj * 2;
#pragma unroll
                    for (int e = 0; e < 16; ++e) { *(LAS bf16*)(RT + (128 + c0 + e) * 144 + row * 2) = (bf16)f2bf(acc[e] * bg);
                        *(bf16*)(dst + e * 16) = (bf16)f2bf(acc[e] * egl); }
                } else {
#pragma unroll
                    for (int e = 0; e < 16; ++e) *(LAS bf16*)(RT + (c0 + e) * 144 + row * 2) = (bf16)f2bf(acc[e] * be);
                }
            }
        }
        GBAR();
        if (k + 1 < nch) g1_issue_raw(rbase + (size_t)(k + 1) * 64 * LDP * 2, roff, raw, wave);
        {
            const int fr = lane & 15, fq = lane >> 4;
#pragma unroll
            for (int i = 0; i < 4; ++i) {
                const int id = wave * 4 + i, mat = id >> 4, ct = (id >> 2) & 3, jt = id & 3;
                f32x4 acc = {0.f, 0.f, 0.f, 0.f};
                if (jt <= ct) {
                    const LAS unsigned char* ap = (mat ? qb : kb) + (16 * ct + fr) * 272 + fq * 16;
                    const LAS unsigned char* bp = kb + (16 * jt + fr) * 272 + fq * 16;
#pragma unroll
                    for (int ks = 0; ks < 4; ++ks) acc = __builtin_amdgcn_mfma_f32_16x16x32_bf16(*(const LAS bf16x8*)(ap + ks * 64), *(const LAS bf16x8*)(bp + ks * 64), acc, 0, 0, 0);
                }
                const int j = 16 * jt + fr; const float gj = sc[j];
#pragma unroll
                for (int r = 0; r < 4; ++r) { const int ii = 16 * ct + 4 * fq + r; const float dec = __expf(fminf(sc[ii] - gj, 0.f));
                    if (mat == 0) Amat[ii * 68 + (j & 7) * 8 + (j >> 3)] = (j < ii) ? acc[r] * sc[64 + ii] * dec : 0.f;
                    else { const float v = (j <= ii) ? acc[r] * dec : 0.f;
                        *(LAS bf16*)(QKs + (ct * 2 + (jt >> 1)) * 1024 + ((4 * fq + r) + 16 * (fr >> 2)) * 16 + ((fr & 3) + 4 * (jt & 1)) * 2) = (bf16)f2bf(v); } }
            }
        }
        GBAR();
        *(v4u*)(rec + GR_QK + tid * 16) = *(const LAS v4u*)(QKs + tid * 16);
        {
            const int cl = lane >> 3, part = lane & 7, c = wave * 8 + cl;
            float tc[8], pm[8];
#pragma unroll
            for (int m = 0; m < 8; ++m) { tc[m] = (m == (c >> 3) && part == (c & 7)) ? 1.f : 0.f; pm[m] = (part == m) ? 1.f : 0.f; }
            f32x4 na0 = *(const LAS f32x4*)(Amat + 1 * 68 + part * 8), na1 = (f32x4){0.f, 0.f, 0.f, 0.f};
#pragma unroll
            for (int i = 1; i < 64; ++i) {
                const f32x4 a0 = na0, a1 = na1;
                if (i + 1 < 64) { const LAS f32x4* ar = (const LAS f32x4*)(Amat + (i + 1) * 68 + part * 8); na0 = ar[0]; if (i + 1 > 32) na1 = ar[1]; }
                asm volatile("" ::: "memory");
                float s0 = a0.x * tc[0], s1 = a0.y * tc[1];
                if (i > 16) { s0 += a0.z * tc[2]; s1 += a0.w * tc[3]; } else if (i > 8) { s0 += a0.z * tc[2]; }
                if (i > 32) { s0 += a1.x * tc[4]; if (i > 40) s1 += a1.y * tc[5]; if (i > 48) s0 += a1.z * tc[6]; if (i > 56) s1 += a1.w * tc[7]; }
                const float s = sum8(s0 + s1);
                tc[i >> 3] = fmaf(-s, pm[i & 7], tc[i >> 3]);
            }
#pragma unroll
            for (int m = 0; m < 8; ++m) *(LAS bf16*)(Tb + (part + 8 * m) * 144 + c * 2) = (bf16)f2bf(tc[m]);
        }
        GBAR();
        {
            const int fr = lane & 15, fq = lane >> 4;
#pragma unroll
            for (int nt = 0; nt < 2; ++nt) {
                const int col = 32 * wave + 16 * nt + fr;
                f32x4 acc[4];
                const LAS unsigned char* bp = RT + col * 144 + fq * 16;
                const bf16x8 b0 = *(const LAS bf16x8*)bp, b1 = *(const LAS bf16x8*)(bp + 64);
#pragma unroll
                for (int ct = 0; ct < 4; ++ct) { const LAS unsigned char* ap = Tb + (16 * ct + fr) * 144 + fq * 16;
                    acc[ct] = (f32x4){0.f, 0.f, 0.f, 0.f};
                    acc[ct] = __builtin_amdgcn_mfma_f32_16x16x32_bf16(*(const LAS bf16x8*)ap, b0, acc[ct], 0, 0, 0);
                    acc[ct] = __builtin_amdgcn_mfma_f32_16x16x32_bf16(*(const LAS bf16x8*)(ap + 64), b1, acc[ct], 0, 0, 0); }
                if (wave < 4) {
                    v4u o0, o1; o0.x = pk2(acc[0][0], acc[0][1]); o0.y = pk2(acc[0][2], acc[0][3]); o0.z = pk2(acc[1][0], acc[1][1]); o0.w = pk2(acc[1][2], acc[1][3]);
                    o1.x = pk2(acc[2][0], acc[2][1]); o1.y = pk2(acc[2][2], acc[2][3]); o1.z = pk2(acc[3][0], acc[3][1]); o1.w = pk2(acc[3][2], acc[3][3]);
                    bf16* dst = UF + (((size_t)ci * 8 + (2 * wave + nt)) * 64 + lane) * 16;
                    *(v4u*)dst = o0; *(v4u*)(dst + 8) = o1;
                } else {
#pragma unroll
                    for (int ct = 0; ct < 4; ++ct)
#pragma unroll
                        for (int r = 0; r < 4; ++r)
                            *(LAS bf16*)(Ws + (ct * 4 + (wave - 4)) * 1024 + ((4 * fq + r) + 16 * (fr >> 2)) * 16 + ((fr & 3) + 4 * nt) * 2) = (bf16)f2bf(-acc[ct][r]);
                }
            }
        }
        GBAR();
        *(v4u*)(rec + GR_W + tid * 16) = *(const LAS v4u*)(Ws + tid * 16);
        *(v4u*)(rec + GR_W + 8192 + tid * 16) = *(const LAS v4u*)(Ws + 8192 + tid * 16);
    }
    asm volatile("s_waitcnt vmcnt(0) lgkmcnt(0)" ::: "memory");
    __syncthreads();
}
__device__ __forceinline__ bf16x8 pack_b(const f32x4 t0, const f32x4 t1) {
    v4u w; w.x = pk2(t0[0], t0[1]); w.y = pk2(t0[2], t0[3]); w.z = pk2(t1[0], t1[1]); w.w = pk2(t1[2], t1[3]);
    return *reinterpret_cast<bf16x8*>(&w);
}
constexpr int G2_OB = 2 * GREC, G2_OBP = 272;
__device__ __forceinline__ void gdn_scan8(const unsigned char* REC, const bf16* UF, const float* EG, bf16* OA, const bf16* P, const float* norm_w, LAS unsigned char* lds, int bh) {
    const int tid = threadIdx.x, lane = tid & 63, wave = __builtin_amdgcn_readfirstlane(tid >> 6);
    const int b = bh / NH, h = bh % NH, fr = lane & 15, fq = lane >> 4;
    const unsigned char* recb = REC + (size_t)bh * 64 * GREC;
#define GSTAGE(nn, bufi) do { _Pragma("unroll") for (int i_ = 0; i_ < 7; ++i_) { const int p_ = wave + 8 * i_; \
        __builtin_amdgcn_global_load_lds((const unsigned*)(recb + (size_t)(nn) * GREC + p_ * 1024 + lane * 16), (LAS unsigned*)(lds + (bufi) * GREC + p_ * 1024), 16, 0, 0); } } while (0)
    f32x4 S[8];
#pragma unroll
    for (int i = 0; i < 8; ++i) S[i] = (f32x4){0.f, 0.f, 0.f, 0.f};
    const bf16* ufp = UF + (((size_t)bh * 64 * 8 + wave) * 64 + lane) * 16;
    float w8[8];
#pragma unroll
    for (int j = 0; j < 8; ++j) w8[j] = norm_w[fr * 8 + j];
    const bf16* zp = P + ((size_t)b * SEQ + 8 * wave + fq) * LDP + PC_ZA + h * HD + fr * 8;
    bf16* op = OA + ((size_t)b * SEQ + 8 * wave + fq) * HW + h * HD + fr * 8;
    v4u u0 = *(const v4u*)ufp, u1 = *(const v4u*)(ufp + 8); float eg = EG[bh * 64];
    v4u z0 = {0u, 0u, 0u, 0u}, z1 = {0u, 0u, 0u, 0u};
    GSTAGE(0, 0);
    asm volatile("s_waitcnt vmcnt(0)" ::: "memory");
    __syncthreads();
#define G2_NORM_OUT(nn) do { const LAS unsigned char* ob_ = lds + G2_OB + ((nn) & 1) * (64 * G2_OBP) + (8 * wave + fq) * G2_OBP + fr * 16; \
        _Pragma("unroll") for (int j_ = 0; j_ < 2; ++j_) { const v4u x_ = *(const LAS v4u*)(ob_ + j_ * 4 * G2_OBP); const v4u z_ = j_ ? z1 : z0; \
            float v_[8] = {bflo(x_.x), bfhi(x_.x), bflo(x_.y), bfhi(x_.y), bflo(x_.z), bfhi(x_.z), bflo(x_.w), bfhi(x_.w)}; \
            const float zz_[8] = {bflo(z_.x), bfhi(z_.x), bflo(z_.y), bfhi(z_.y), bflo(z_.z), bfhi(z_.z), bflo(z_.w), bfhi(z_.w)}; \
            float ss_ = 0.f; _Pragma("unroll") for (int e_ = 0; e_ < 8; ++e_) ss_ += v_[e_] * v_[e_]; \
            ss_ = sum16(ss_); const float rs_ = 1.0f / sqrtf(ss_ * (1.0f / HD) + EPS); \
            _Pragma("unroll") for (int e_ = 0; e_ < 8; ++e_) v_[e_] = v_[e_] * rs_ * w8[e_] * silu_f(zz_[e_]); \
            v4u o_; o_.x = pk2(v_[0], v_[1]); o_.y = pk2(v_[2], v_[3]); o_.z = pk2(v_[4], v_[5]); o_.w = pk2(v_[6], v_[7]); \
            *(v4u*)(op + ((size_t)(nn) * 64 + 4 * j_) * HW) = o_; } } while (0)
    for (int n = 0; n < 64; ++n) {
        if (n > 0) G2_NORM_OUT(n - 1);
        f32x4 Vn[4], O[4]; const float egc = eg;
        Vn[0] = (f32x4){bflo(u0.x), bfhi(u0.x), bflo(u0.y), bfhi(u0.y)}; Vn[1] = (f32x4){bflo(u0.z), bfhi(u0.z), bflo(u0.w), bfhi(u0.w)};
        Vn[2] = (f32x4){bflo(u1.x), bfhi(u1.x), bflo(u1.y), bfhi(u1.y)}; Vn[3] = (f32x4){bflo(u1.z), bfhi(u1.z), bflo(u1.w), bfhi(u1.w)};
        { const bf16* zq = zp + (size_t)n * 64 * LDP; z0 = *(const v4u*)zq; z1 = *(const v4u*)(zq + (size_t)4 * LDP); }
        if (n + 1 < 64) { const bf16* up = ufp + (size_t)(n + 1) * (8 * 64 * 16); u0 = *(const v4u*)up; u1 = *(const v4u*)(up + 8); eg = EG[bh * 64 + n + 1]; }
        __builtin_amdgcn_sched_barrier(0);
        if (n + 1 < 64) GSTAGE(n + 1, (n + 1) & 1);
        __builtin_amdgcn_sched_barrier(0);
        bf16x8 Sb[4];
#pragma unroll
        for (int ks = 0; ks < 4; ++ks) Sb[ks] = pack_b(S[2 * ks], S[2 * ks + 1]);
        const LAS unsigned char* base = lds + (n & 1) * GREC + lane * 16;
#pragma unroll
        for (int ct = 0; ct < 4; ++ct) { O[ct] = (f32x4){0.f, 0.f, 0.f, 0.f};
#pragma unroll
            for (int ks = 0; ks < 4; ++ks) {
                Vn[ct] = __builtin_amdgcn_mfma_f32_16x16x32_bf16(*(const LAS bf16x8*)(base + GR_W + (ct * 4 + ks) * 1024), Sb[ks], Vn[ct], 0, 0, 0);
                O[ct] = __builtin_amdgcn_mfma_f32_16x16x32_bf16(*(const LAS bf16x8*)(base + GR_Q + (ct * 4 + ks) * 1024), Sb[ks], O[ct], 0, 0, 0); } }
        bf16x8 Vb[2];
        Vb[0] = pack_b(Vn[0], Vn[1]); Vb[1] = pack_b(Vn[2], Vn[3]);
#pragma unroll
        for (int ct = 0; ct < 4; ++ct)
#pragma unroll
            for (int ks = 0; ks < 2; ++ks) O[ct] = __builtin_amdgcn_mfma_f32_16x16x32_bf16(*(const LAS bf16x8*)(base + GR_QK + (ct * 2 + ks) * 1024), Vb[ks], O[ct], 0, 0, 0);
#pragma unroll
        for (int dt = 0; dt < 8; ++dt) { S[dt] = S[dt] * egc;
#pragma unroll
            for (int ks = 0; ks < 2; ++ks) S[dt] = __builtin_amdgcn_mfma_f32_16x16x32_bf16(*(const LAS bf16x8*)(base + GR_K + (dt * 2 + ks) * 1024), Vb[ks], S[dt], 0, 0, 0); }
        { LAS unsigned char* ow = lds + G2_OB + (n & 1) * (64 * G2_OBP) + (4 * fq) * G2_OBP + (16 * wave + fr) * 2;
#pragma unroll
          for (int ct = 0; ct < 4; ++ct)
#pragma unroll
              for (int r = 0; r < 4; ++r) *(LAS bf16*)(ow + (16 * ct + r) * G2_OBP) = (bf16)f2bf(O[ct][r]); }
        asm volatile("s_waitcnt vmcnt(0)" ::: "memory");
        __syncthreads();
    }
    G2_NORM_OUT(63);
#undef G2_NORM_OUT
#undef GSTAGE
    __syncthreads();
}
__device__ __forceinline__ int fox_jlo(const unsigned* CB, int bh, int qb, float skipT, float be, int lane) {
    const float b0 = __builtin_bit_cast(float, __builtin_amdgcn_readfirstlane(__builtin_bit_cast(int, ((const float*)CB)[((size_t)bh * 64 + 4 * qb) * 64])));
    const unsigned long long m = __ballot((lane < 4 * qb) && (b0 - be > skipT));
    return __builtin_amdgcn_readfirstlane((int)__popcll(m));
}
__device__ __forceinline__ fox::BlockRef fox_mkref(bf16* P, bf16* OB, unsigned* CB, int bh, int qb, int jlo) {
    const int b = bh / NH, h = bh % NH;
    fox::BlockRef r; const size_t row0 = (size_t)b * SEQ, rowk = row0 + (size_t)jlo * fox::KVBLK;
    r.Q = P + (row0 + (size_t)qb * fox::QB) * LDP + PC_QB + h * HD; r.K = P + rowk * LDP + PC_KB + h * HD; r.V = P + rowk * LDP + PC_VB + h * HD;
    r.O = OB + (row0 + (size_t)qb * fox::QB) * HW + h * HD; r.CB = (const fox::f32x2*)CB + ((size_t)bh * 64 + jlo) * 32; r.P0 = qb * fox::QB - jlo * fox::KVBLK; return r;
}
#ifndef MK_N_LAUNCHES
#define MK_N_LAUNCHES 1
#endif
constexpr int N_PHASES = 10;
#ifndef REP_PHASE
#define REP_PHASE -1
#endif
struct Args { const float* in[17]; float* out; unsigned char* ws; int ph_lo, ph_hi; };
__global__ void __launch_bounds__(NWAVES * 64, 2) mk_fwd(Args args) {
    extern __shared__ __attribute__((aligned(16))) unsigned char lds_raw[];
    LAS unsigned char* lds = (LAS unsigned char*)lds_raw;
    volatile LAS unsigned* MISC = (volatile LAS unsigned*)(lds + MISC_OFF);
    const int tid = threadIdx.x, lane = tid & 63, wave = __builtin_amdgcn_readfirstlane(tid >> 6);
    const int G = gridDim.x, bx = blockIdx.x;
    const int vcu = (G % 8 == 0) ? (bx % 8) * (G / 8) + bx / 8 : bx;
    const int gw = vcu * NWAVES + wave, NGW = G * NWAVES;
    unsigned char* ws = args.ws;
    const float* x = args.in[0]; const float* norm_mix_w = args.in[1]; const float* w_in = args.in[2]; const float* conv_w = args.in[3];
    const float* a_log = args.in[4]; const float* dt_bias = args.in[5]; const float* gdn_norm_w = args.in[6]; const float* fox_b_f = args.in[7];
    const float* fox_qn = args.in[8]; const float* fox_kn = args.in[9]; const float* w_ba = args.in[10]; const float* w_bb = args.in[11];
    const float* w_out = args.in[12]; const float* norm_ffn_w = args.in[13]; const float* w_g = args.in[14]; const float* w_u = args.in[15]; const float* w_d = args.in[16];
    float* out = args.out;
    bf16* WIN = (bf16*)(ws + WS_WIN); bf16* WSM = (bf16*)(ws + WS_WSM); bf16* WA = (bf16*)(ws + WS_WA); bf16* WB = (bf16*)(ws + WS_WB); bf16* WO = (bf16*)(ws + WS_WO);
    bf16* WGU = (bf16*)(ws + WS_WGU); bf16* WD = (bf16*)(ws + WS_WD); bf16* XN = (bf16*)(ws + WS_XN); bf16* OA = (bf16*)(ws + WS_OA); bf16* OB = (bf16*)(ws + WS_OB);
    float* SMALL = (float*)(ws + WS_SMALL); unsigned* CB = (unsigned*)(ws + WS_CB); bf16* P = (bf16*)(ws + WS_P); bf16* HN = (bf16*)(ws + WS_HN); bf16* ACT = (bf16*)(ws + WS_ACT);
    bf16* HB = (bf16*)(ws + WS_XN);
    bf16* MG = (bf16*)(ws + WS_MG); bf16* UF = (bf16*)(ws + WS_UF); float* EGp = (float*)(ws + WS_EG);
    unsigned* ctl = (unsigned*)(ws + WS_CTL);

    for (int u = tid; u < (LDS_BYTES - LDSCTL_OFF) / 4; u += NWAVES * 64) ((LAS unsigned*)(lds + LDSCTL_OFF))[u] = 0u;
    __syncthreads();
    XcdBarrier bar; bar.bar = ctl + CW_BAR; bar.x = 0; bar.st = nullptr;
    const int lo = args.ph_lo, hi = args.ph_hi;
    if (hi - lo > 1) bar = xcd_barrier_post(ctl + CW_BAR, MISC + 8);
#ifndef PHASE_MASK
#define PHASE_MASK 0xFFFF
#endif
#define IN(k) (((PHASE_MASK >> (k)) & 1) && lo <= (k) && (k) < hi)
#define SEAM(k) do { if (IN(k) && IN((k) + 1)) xcd_barrier(bar); } while (0)

    const bool wd_late = (G == 256) && IN(0) && IN(8);
    const bool fused01 = (hi - lo > 1) && IN(0) && IN(1) && G == 256;
    if (IN(0)) {
        LAS float* scr = (LAS float*)(lds + RING_OFF + wave * 16384);
        for (int idx = (vcu * NWAVES * 64 + tid); idx < NSM * DM; idx += G * NWAVES * 64) { const int r = idx / DM, k = idx - r * DM;
            const int col = r < 16 ? SC_BETA + r : r < 32 ? SC_ALPHA + (r - 16) : SC_F + (r - 32);
            WSM[idx] = (bf16)f2bf(w_in[(size_t)k * N_IN + col]); }
        if (fused01) {
            xcd_barrier(bar);
            for (int j = 0; j < 8; ++j) { const int m = vcu * 64 + wave * 8 + j; rms_row_to_bf16(x + (size_t)m * DM, norm_mix_w, XN + (size_t)m * DM, lane); }
            asm volatile("s_waitcnt vmcnt(0)" ::: "memory"); __syncthreads();
            if (wave < 4) small_gemm(XN, WSM, SMALL, 0, 1, lane, vcu * 4 + wave);
        } else {
            for (int m = gw; m < M; m += NGW) rms_row_to_bf16(x + (size_t)m * DM, norm_mix_w, XN + (size_t)m * DM, lane);
        }
        transpose_items(w_in, DM, N_IN, 0, 8192, 1 << 30, 0, 0, WIN, scr, gw, NGW, lane);
        transpose_items(w_in, DM, N_IN, SC_QB, 6144, 1 << 30, 0, PC_QB, WIN, scr, gw, NGW, lane);
        transpose_items(w_in, DM, N_IN, SC_GA, 8192, 1 << 30, 0, PC_GA, WIN, scr, gw, NGW, lane);
        transpose_items(w_ba, HW, DM, 0, DM, 1 << 30, 0, 0, WA, scr, gw, NGW, lane);
        transpose_items(w_bb, HW, DM, 0, DM, 1 << 30, 0, 0, WB, scr, gw, NGW, lane);
        transpose_items(w_out, DM, DM, 0, DM, 1 << 30, 0, 0, WO, scr, gw, NGW, lane);
        transpose_items(w_g, DM, DFF, 0, DFF, 128, 256, 0, WGU, scr, gw, NGW, lane);
        transpose_items(w_u, DM, DFF, 0, DFF, 128, 256, 128, WGU, scr, gw, NGW, lane);
        if (!wd_late) transpose_items(w_d, DFF, DM, 0, DM, 1 << 30, 0, 0, WD, scr, gw, NGW, lane);
    }
    SEAM(0);
    if (IN(1)) {
        if (!fused01) small_gemm(XN, WSM, SMALL, gw, NGW, lane);
        pg8::Gemm g{XN, WIN, M, LDP, DM}; pg8::StaticOrder S; S.init(M, LDP, G, bx);
        pg8::EpiStoreBf16 E{P, LDP, fox_qn, fox_kn, (LAS float*)(lds + RING_OFF + 131072), PC_QB / 256, PC_KB / 256, PC_VB / 256, EPS};
        pg8::gemm_phase<pg8::EpiStoreBf16, pg8::StaticOrder, true, true>(lds + RING_OFF, g, S, E);
    }
    SEAM(1);
    if (IN(2)) {
        if (bx < BATCH * NH) fox_cumsum_wg(SMALL, fox_b_f, CB, bx, (LAS float*)(lds + RING_OFF));
        for (int idx = bx; idx < 4 * BATCH * NH; idx += G) gdn_prep_wg(P, SMALL, conv_w, a_log, dt_bias, (unsigned char*)out, UF, EGp, lds + RING_OFF, (idx >> 2) & 63, (idx & 3) * 16, 16);
    }
    SEAM(2);
    if (IN(3)) {
        typedef fox::Body<LDP, HW> FB;
        char* albs = (char*)lds_raw + RING_OFF;
        if (bx < BATCH * NH) gdn_scan8((const unsigned char*)out, UF, EGp, OA, P, gdn_norm_w, lds + RING_OFF, bx);
        float skipT;
        { float mq = fmaxf(fabsf(fox_qn[lane]), fabsf(fox_qn[64 + lane])), mk = fmaxf(fabsf(fox_kn[lane]), fabsf(fox_kn[64 + lane]));
#pragma unroll
          for (int o = 1; o < 64; o <<= 1) { mq = fmaxf(mq, __shfl_xor(mq, o)); mk = fmaxf(mk, __shfl_xor(mk, o)); }
          const float Bq = 11.3137085f * 1.02f * mq * mk;
          skipT = __builtin_bit_cast(float, __builtin_amdgcn_readfirstlane(__builtin_bit_cast(int, 11.3137085f * (92.9f + 2.0f * Bq + 3.0f)))); }
        constexpr int NITEMS = BATCH * NH * (SEQ / fox::QB);
        unsigned* qhead = ctl + CW_QUEUE;
#define FOX_FETCH(slot) do { if (tid == 0) MISC[12 + (slot)] = xb_add(qhead, 1u); } while (0)
#define FOX_REF(it) fox_mkref(P, OB, CB, (int)((it) & 63u), 15 - (int)((it) >> 6), fox_jlo(CB, (int)((it) & 63u), 15 - (int)((it) >> 6), skipT, ((const float*)CB)[((size_t)((it) & 63u) * 64 + lane) * 64 + 63], lane))
        FOX_FETCH(0); FOX_FETCH(1);
        __syncthreads();
        unsigned it0 = (unsigned)__builtin_amdgcn_readfirstlane((int)MISC[12]), it1 = (unsigned)__builtin_amdgcn_readfirstlane((int)MISC[13]);
        __syncthreads();
        if (it0 < (unsigned)NITEMS) {
            fox::BlockRef cur = FOX_REF(it0);
            fox::Seam Sm;
            FB::prime(cur, albs, Sm);
            for (;;) {
                const bool more = it1 < (unsigned)NITEMS;
                if (more) FOX_FETCH(0);
                const fox::BlockRef nxt = more ? FOX_REF(it1) : cur;
                FB::block(cur, nxt, SEQ, albs, Sm);
                if (!more) break;
                cur = nxt; it1 = (unsigned)__builtin_amdgcn_readfirstlane((int)MISC[12]);
                __syncthreads();
            }
        }
#undef FOX_FETCH
#undef FOX_REF
    }
    SEAM(3);
    if (IN(4)) {
        pg8::Gemm g{OA, WA, M, DM, HW}; pg8::StaticOrder S; S.init(M, DM, G, bx);
        pg8::EpiBranch<true> E{MG, DM, P + PC_GA, LDP};
        pg8::gemm_phase<pg8::EpiBranch<true>, pg8::StaticOrder, true, true>(lds + RING_OFF, g, S, E);
    }
    if (IN(4) && IN(5)) { asm volatile("s_waitcnt vmcnt(0)" ::: "memory"); __syncthreads(); }
    if (IN(5)) {
        pg8::Gemm g{OB, WB, M, DM, HW}; pg8::StaticOrder S; S.init(M, DM, G, bx);
        pg8::EpiBranch<false> E{MG, DM, P + PC_GB, LDP};
        pg8::gemm_phase<pg8::EpiBranch<false>, pg8::StaticOrder, true, true>(lds + RING_OFF, g, S, E);
    }
    SEAM(5);
    if (IN(6)) {
        pg8::Gemm g{MG, WO, M, DM, DM}; pg8::StaticOrder S; S.init(M, DM, G, bx);
        pg8::EpiResidToBf16 E{x, HB, DM};
        pg8::gemm_phase<pg8::EpiResidToBf16, pg8::StaticOrder, true, true>(lds + RING_OFF, g, S, E);
    }
    SEAM(6);
    if (IN(7)) {
        for (int m = gw; m < M; m += NGW) rms_row_bf16_to_bf16(HB + (size_t)m * DM, norm_ffn_w, HN + (size_t)m * DM, lane);
    }
    SEAM(7);
    if (IN(8)) {
        pg8::Gemm g{HN, WGU, M, 2 * DFF, DM}; pg8::StaticOrder S; S.init(M, 2 * DFF, G, bx);
        pg8::EpiSwiglu E{ACT, DFF};
        pg8::gemm_phase<pg8::EpiSwiglu, pg8::StaticOrder, true, true>(lds + RING_OFF, g, S, E);
        if (wd_late && bx >= (M / 256) * (2 * DFF / 256) % 256) {
            LAS float* scr = (LAS float*)(lds + RING_OFF + wave * 16384);
            transpose_items_pipe(w_d, DFF, DM, 0, DM, 1 << 30, 0, 0, WD, scr, (bx - 128) * NWAVES + wave, 128 * NWAVES, lane);
        }
    }
    SEAM(8);
    if (IN(9)) {
        pg8::Gemm g{ACT, WD, M, DM, DFF}; pg8::StaticOrder S; S.init(M, DM, G, bx);
        pg8::EpiResidFromBf16 E{HB, out, DM};
        pg8::gemm_phase<pg8::EpiResidFromBf16, pg8::StaticOrder, true, true>(lds + RING_OFF, g, S, E);
    }
#undef IN
#undef SEAM
}

extern "C" void kernel_launch(void* const* d_in, const int* in_sizes, int n_in, void* d_out, int out_size, void* d_ws, size_t ws_size, hipStream_t stream) {
    static int grid = 0;
    if (grid == 0) {
        if (n_in != 17 || in_sizes[0] != M * DM || out_size != M * DM || ws_size < WS_END) {
            fprintf(stderr, "kernel_launch: unexpected shapes (n_in %d, in0 %d, out %d, ws %zu < %zu); nothing launched\n", n_in, n_in > 0 ? in_sizes[0] : -1, out_size, ws_size, (size_t)WS_END); grid = -1; return; }
        int dev = 0, cus = 0, per_cu = 0;
        if (hipGetDevice(&dev) != hipSuccess || hipDeviceGetAttribute(&cus, hipDeviceAttributeMultiprocessorCount, dev) != hipSuccess) { grid = -1; return; }
        if (hipFuncSetAttribute((const void*)mk_fwd, hipFuncAttributeMaxDynamicSharedMemorySize, LDS_BYTES) != hipSuccess) { fprintf(stderr, "kernel_launch: hipFuncSetAttribute failed\n"); grid = -1; return; }
        if (hipOccupancyMaxActiveBlocksPerMultiprocessor(&per_cu, (const void*)mk_fwd, NWAVES * 64, LDS_BYTES) != hipSuccess || per_cu < 1)
            fprintf(stderr, "kernel_launch: note: occupancy query reports %d workgroups per CU\n", per_cu);
        (void)hipGetLastError();
        grid = cus;
    }
    if (grid < 0) return;
    (void)hipMemsetAsync((char*)d_ws + WS_CTL, 0, CTL_ZERO_BYTES, stream);
    Args a{};
    for (int i = 0; i < 17; ++i) a.in[i] = (const float*)d_in[i];
    a.out = (float*)d_out; a.ws = (unsigned char*)d_ws;
#if MK_N_LAUNCHES == 1
    a.ph_lo = 0; a.ph_hi = N_PHASES;
    hipLaunchKernelGGL(mk_fwd, dim3(grid), dim3(NWAVES * 64), LDS_BYTES, stream, a);
#else
    for (int p = 0; p < N_PHASES; ++p) { a.ph_lo = p; a.ph_hi = p + 1;
        for (int rep = 0; rep < (p == REP_PHASE ? 2 : 1); ++rep)
        hipLaunchKernelGGL(mk_fwd, dim3(grid), dim3(NWAVES * 64), LDS_BYTES, stream, a); }
#endif
}
```

```cpp
#include <hip/hip_runtime.h>
#include <cstdio>
#include <cstdint>
namespace pg8 {
#define PG8_LAS __attribute__((address_space(3)))
typedef unsigned short bf16_t;
typedef short bf16x8 __attribute__((ext_vector_type(8)));
typedef float f32x4 __attribute__((ext_vector_type(4)));
typedef unsigned u32x4 __attribute__((ext_vector_type(4)));
constexpr int BM = 256, BK = 64, HALF = 128, HTB = HALF * BK * 2  , STAGE_BYTES = 8 * HTB, NXCD = 8, WGM = 4;

__host__ __device__ __forceinline__ int lds_byte(int r, int c) { const int st = (r >> 4) * 2 + (c >> 5), rr = r & 15, cc = c & 31, ob = rr * 64 + cc * 2; return st * 1024 + (ob ^ (((ob >> 9) & 1) << 5)); }
__host__ __device__ __forceinline__ void stage_rc(int b, int& R, int& C) { const int st = b / 1024, sb = b % 1024, swz = sb ^ (((sb >> 9) & 1) << 5); R = (st >> 1) * 16 + swz / 64; C = (st & 1) * 32 + (swz % 64) / 2; }
__host__ __device__ __forceinline__ int perm32(int rho) { const int n = rho >> 4, i = rho & 15; return 8 * (i >> 2) + 4 * n + (i & 3); }

struct Unit { int pm, pn; };
struct Gemm { const bf16_t* A; const bf16_t* Bt; int M, N, K; };

struct StaticOrder {
    int nM, nN, nwg, G, c;
    __host__ __device__ void init(int M, int N, int G_, int c_) { nM = M / BM; nN = N / BM; nwg = nM * nN; G = G_; c = c_; }
    __host__ __device__ bool next(int i, Unit& u) const {
        const long L = (long)i * G + c; if (L >= nwg) return false;
        int wgid = (int)L; { const int q = nwg / NXCD, r = nwg % NXCD, xcd = wgid % NXCD, off = wgid / NXCD; wgid = (xcd < r ? xcd * (q + 1) : r * (q + 1) + (xcd - r) * q) + off; }
        const int nig = WGM * nN, gid = wgid / nig, fm = gid * WGM, gsz = (nM - fm) < WGM ? (nM - fm) : WGM;
        u.pm = fm + ((wgid % nig) % gsz); u.pn = (wgid % nig) / gsz; return true;
    }
    __device__ __forceinline__ void a_ready(const Unit&) const {}
    __device__ __forceinline__ void done(const Unit&) const {}
};

__device__ __forceinline__ unsigned cvt_pk_bf16(float lo, float hi) { unsigned r; asm volatile("v_cvt_pk_bf16_f32 %0, %1, %2" : "=v"(r) : "v"(lo), "v"(hi)); return r; }
__device__ __forceinline__ float bf_lo(unsigned w) { return __uint_as_float(w << 16); }
__device__ __forceinline__ float bf_hi(unsigned w) { return __uint_as_float(w & 0xffff0000u); }
__device__ __forceinline__ float sigmoid_f(float x) { return __builtin_amdgcn_rcpf(1.0f + __builtin_amdgcn_exp2f(-1.4426950408889634f * x)); }

struct EpiStoreBf16 {
    static constexpr bool PERM = true, AFTER_DRAIN = false;
    bf16_t* O; int ldc; const float* wq; const float* wk; PG8_LAS float* part; int qn_lo, qn_mid, qn_hi; float eps;
    __device__ __forceinline__ void operator()(const f32x4 (&acc)[2][2][4][2], const Unit& u, int wr, int wc, int fr, int fq) const {
        const int row0 = u.pm * BM + wr * 64 + fr, col0 = u.pn * BM + wc * 32 + 8 * fq;
        if (u.pn >= qn_lo && u.pn < qn_hi) {
            const float* wp = (u.pn < qn_mid ? wq : wk) + wc * 32 + 8 * fq;
            const f32x4 w0 = *(const f32x4*)wp, w1 = *(const f32x4*)(wp + 4);
#pragma unroll
            for (int ai = 0; ai < 2; ++ai)
#pragma unroll
                for (int m = 0; m < 4; ++m)
#pragma unroll
                    for (int bj = 0; bj < 2; ++bj) { const f32x4 v0 = acc[ai][bj][m][0], v1 = acc[ai][bj][m][1];
                        float ss = v0[0] * v0[0] + v0[1] * v0[1] + v0[2] * v0[2] + v0[3] * v0[3] + v1[0] * v1[0] + v1[1] * v1[1] + v1[2] * v1[2] + v1[3] * v1[3];
                        ss += __shfl_xor(ss, 16); ss += __shfl_xor(ss, 32);
                        if (fq == 0) part[(ai * HALF + wr * 64 + m * 16 + fr) * 8 + bj * 4 + wc] = ss; }
            asm volatile("s_waitcnt lgkmcnt(0)" ::: "memory"); __builtin_amdgcn_s_barrier(); asm volatile("" ::: "memory");
#pragma unroll
            for (int ai = 0; ai < 2; ++ai)
#pragma unroll
                for (int m = 0; m < 4; ++m) { bf16_t* rowp = O + (size_t)(row0 + ai * HALF + m * 16) * ldc + col0;
#pragma unroll
                    for (int bj = 0; bj < 2; ++bj) { const f32x4 p = *(const PG8_LAS f32x4*)(part + (ai * HALF + wr * 64 + m * 16 + fr) * 8 + bj * 4);
                        const float rs = 1.0f / sqrtf((p[0] + p[1] + p[2] + p[3]) * (1.0f / 128.0f) + eps);
                        const f32x4 v0 = acc[ai][bj][m][0], v1 = acc[ai][bj][m][1];
                        u32x4 w; w.x = cvt_pk_bf16(v0[0] * rs * w0[0], v0[1] * rs * w0[1]); w.y = cvt_pk_bf16(v0[2] * rs * w0[2], v0[3] * rs * w0[3]);
                        w.z = cvt_pk_bf16(v1[0] * rs * w1[0], v1[1] * rs * w1[1]); w.w = cvt_pk_bf16(v1[2] * rs * w1[2], v1[3] * rs * w1[3]);
                        *(u32x4*)(rowp + bj * HALF) = w; } }
            return;
        }
#pragma unroll
        for (int ai = 0; ai < 2; ++ai)
#pragma unroll
            for (int m = 0; m < 4; ++m) { bf16_t* rowp = O + (size_t)(row0 + ai * HALF + m * 16) * ldc + col0;
#pragma unroll
                for (int bj = 0; bj < 2; ++bj) { const f32x4 v0 = acc[ai][bj][m][0], v1 = acc[ai][bj][m][1];
                    u32x4 w; w.x = cvt_pk_bf16(v0[0], v0[1]); w.y = cvt_pk_bf16(v0[2], v0[3]); w.z = cvt_pk_bf16(v1[0], v1[1]); w.w = cvt_pk_bf16(v1[2], v1[3]);
                    *(u32x4*)(rowp + bj * HALF) = w; } }
    }
};
template <bool FIRST> struct EpiBranch {
    static constexpr bool PERM = true, AFTER_DRAIN = false;
    bf16_t* MG; int ldm; const bf16_t* G; int ldg;
    __device__ __forceinline__ void operator()(const f32x4 (&acc)[2][2][4][2], const Unit& u, int wr, int wc, int fr, int fq) const {
        const int row0 = u.pm * BM + wr * 64 + fr, col0 = u.pn * BM + wc * 32 + 8 * fq;
#pragma unroll
        for (int ai = 0; ai < 2; ++ai) {
            u32x4 gl[4][2], pl[4][2];
#pragma unroll
            for (int m = 0; m < 4; ++m)
#pragma unroll
                for (int bj = 0; bj < 2; ++bj) { const size_t r = (size_t)(row0 + ai * HALF + m * 16); const int c = col0 + bj * HALF;
                    gl[m][bj] = *(const u32x4*)(G + r * ldg + c); if (!FIRST) pl[m][bj] = *(const u32x4*)(MG + r * ldm + c); }
#pragma unroll
            for (int m = 0; m < 4; ++m)
#pragma unroll
                for (int bj = 0; bj < 2; ++bj) { const size_t r = (size_t)(row0 + ai * HALF + m * 16); const int c = col0 + bj * HALF;
                    const u32x4 g = gl[m][bj]; const f32x4 a0 = acc[ai][bj][m][0], a1 = acc[ai][bj][m][1];
                    float v[8];
                    v[0] = a0[0] * sigmoid_f(bf_lo(g.x)); v[1] = a0[1] * sigmoid_f(bf_hi(g.x)); v[2] = a0[2] * sigmoid_f(bf_lo(g.y)); v[3] = a0[3] * sigmoid_f(bf_hi(g.y));
                    v[4] = a1[0] * sigmoid_f(bf_lo(g.z)); v[5] = a1[1] * sigmoid_f(bf_hi(g.z)); v[6] = a1[2] * sigmoid_f(bf_lo(g.w)); v[7] = a1[3] * sigmoid_f(bf_hi(g.w));
                    if (!FIRST) { const u32x4 p = pl[m][bj];
                        v[0] += bf_lo(p.x); v[1] += bf_hi(p.x); v[2] += bf_lo(p.y); v[3] += bf_hi(p.y); v[4] += bf_lo(p.z); v[5] += bf_hi(p.z); v[6] += bf_lo(p.w); v[7] += bf_hi(p.w); }
                    u32x4 w; w.x = cvt_pk_bf16(v[0], v[1]); w.y = cvt_pk_bf16(v[2], v[3]); w.z = cvt_pk_bf16(v[4], v[5]); w.w = cvt_pk_bf16(v[6], v[7]);
                    *(u32x4*)(MG + r * ldm + c) = w; }
        }
    }
};
struct EpiResidToBf16 {
    static constexpr bool PERM = true, AFTER_DRAIN = false;
    const float* X; bf16_t* HB; int ld;
    __device__ __forceinline__ void operator()(const f32x4 (&acc)[2][2][4][2], const Unit& u, int wr, int wc, int fr, int fq) const {
        const int row0 = u.pm * BM + wr * 64 + fr, col0 = u.pn * BM + wc * 32 + 8 * fq;
#pragma unroll
        for (int ai = 0; ai < 2; ++ai) {
            f32x4 xv[4][2][2];
#pragma unroll
            for (int m = 0; m < 4; ++m)
#pragma unroll
                for (int bj = 0; bj < 2; ++bj) { const size_t off = (size_t)(row0 + ai * HALF + m * 16) * ld + col0 + bj * HALF;
                    xv[m][bj][0] = *(const f32x4*)(X + off); xv[m][bj][1] = *(const f32x4*)(X + off + 4); }
#pragma unroll
            for (int m = 0; m < 4; ++m)
#pragma unroll
                for (int bj = 0; bj < 2; ++bj) { const size_t off = (size_t)(row0 + ai * HALF + m * 16) * ld + col0 + bj * HALF;
                    const f32x4 v0 = xv[m][bj][0] + acc[ai][bj][m][0], v1 = xv[m][bj][1] + acc[ai][bj][m][1];
                    u32x4 w; w.x = cvt_pk_bf16(v0[0], v0[1]); w.y = cvt_pk_bf16(v0[2], v0[3]); w.z = cvt_pk_bf16(v1[0], v1[1]); w.w = cvt_pk_bf16(v1[2], v1[3]);
                    *(u32x4*)(HB + off) = w; }
        }
    }
};
struct EpiResidFromBf16 {
    static constexpr bool PERM = false, AFTER_DRAIN = false;
    const bf16_t* HB; float* OUT; int ld;
    __device__ __forceinline__ void operator()(const f32x4 (&acc)[2][2][4][2], const Unit& u, int wr, int wc, int fr, int fq) const {
        const int row0 = u.pm * BM + wr * 64 + fr, col0 = u.pn * BM + wc * 32 + 4 * fq;
        typedef unsigned u32x2 __attribute__((ext_vector_type(2)));
        u32x2 h[2][4][2][2];
#pragma unroll
        for (int ai = 0; ai < 2; ++ai)
#pragma unroll
            for (int m = 0; m < 4; ++m)
#pragma unroll
                for (int bj = 0; bj < 2; ++bj)
#pragma unroll
                    for (int n = 0; n < 2; ++n) h[ai][m][bj][n] = *(const u32x2*)(HB + (size_t)(row0 + ai * HALF + m * 16) * ld + col0 + bj * HALF + n * 16);
#pragma unroll
        for (int ai = 0; ai < 2; ++ai)
#pragma unroll
            for (int m = 0; m < 4; ++m)
#pragma unroll
                for (int bj = 0; bj < 2; ++bj)
#pragma unroll
                    for (int n = 0; n < 2; ++n) { const u32x2 hh = h[ai][m][bj][n];
                        const f32x4 hv = {bf_lo(hh.x), bf_hi(hh.x), bf_lo(hh.y), bf_hi(hh.y)};
                        *(f32x4*)(OUT + (size_t)(row0 + ai * HALF + m * 16) * ld + col0 + bj * HALF + n * 16) = hv + acc[ai][bj][m][n]; }
    }
};
struct EpiSwiglu {
    static constexpr bool PERM = true, AFTER_DRAIN = false;
    bf16_t* ACT; int ldc;
    __device__ __forceinline__ void operator()(const f32x4 (&acc)[2][2][4][2], const Unit& u, int wr, int wc, int fr, int fq) const {
        const int row0 = u.pm * BM + wr * 64 + fr, col0 = u.pn * HALF + wc * 32 + 8 * fq;
#pragma unroll
        for (int ai = 0; ai < 2; ++ai)
#pragma unroll
            for (int m = 0; m < 4; ++m) { bf16_t* rowp = ACT + (size_t)(row0 + ai * HALF + m * 16) * ldc + col0;
                float v[8];
#pragma unroll
                for (int n = 0; n < 2; ++n)
#pragma unroll
                    for (int j = 0; j < 4; ++j) { const float g = acc[ai][0][m][n][j], up = acc[ai][1][m][n][j]; v[4 * n + j] = g * sigmoid_f(g) * up; }
                u32x4 w; w.x = cvt_pk_bf16(v[0], v[1]); w.y = cvt_pk_bf16(v[2], v[3]); w.z = cvt_pk_bf16(v[4], v[5]); w.w = cvt_pk_bf16(v[6], v[7]);
                *(u32x4*)rowp = w; }
    }
};

template <class Epi, class Sched, bool ALIGN_EPI = false, bool SP2 = false>
__device__ __forceinline__ void gemm_phase(PG8_LAS unsigned char* lds, const Gemm g, const Sched& S, const Epi& E) {
    const int tid = threadIdx.x, wid = __builtin_amdgcn_readfirstlane(tid >> 6), lane = tid & 63, wr = wid >> 2, wc = wid & 3, fr = lane & 15, fq = lane >> 4;
    const int K = g.K, nt = K / BK;
    unsigned voffA[2], voffB[2];
#pragma unroll
    for (int i = 0; i < 2; ++i) { int R, C; stage_rc(tid * 16 + i * 8192, R, C); const int Rb = Epi::PERM ? ((R & ~31) + perm32(R & 31)) : R;
        voffA[i] = (unsigned)(R * K + C) * 2u; voffB[i] = (unsigned)(Rb * K + C) * 2u; }
    const size_t kstep = (size_t)(BK * 2);
    const size_t hstep = (size_t)HALF * K * 2;
    const size_t tstep = 2 * hstep;
    const unsigned ldsw = (unsigned)wid * 1024u;
    const int aoff = lds_byte(wr * 64 + fr, fq * 8), boff = lds_byte(wc * 32 + fr, fq * 8);
#define PG8_SA(b, h) (((b) * 2 + (h)) * HTB)
#define PG8_SB(b, h) ((4 + (b) * 2 + (h)) * HTB)
#define PG8_STAGE(bufoff, gbase, voff) do { _Pragma("unroll") for (int _i = 0; _i < 2; ++_i) \
        __builtin_amdgcn_global_load_lds((const unsigned*)((const char*)(gbase) + (voff)[_i]), (PG8_LAS unsigned*)(lds + (bufoff) + ldsw + _i * 8192), 16, 0, 0); } while (0)
#define PG8_LDA(dst, b, h) do { _Pragma("unroll") for (int m = 0; m < 4; ++m) _Pragma("unroll") for (int k = 0; k < 2; ++k) dst[m][k] = *(const PG8_LAS bf16x8*)(lds + PG8_SA(b, h) + aoff + m * 2048 + k * 1024); } while (0)
#define PG8_LDB(dst, b, h) do { _Pragma("unroll") for (int n = 0; n < 2; ++n) _Pragma("unroll") for (int k = 0; k < 2; ++k) dst[n][k] = *(const PG8_LAS bf16x8*)(lds + PG8_SB(b, h) + boff + n * 2048 + k * 1024); } while (0)
#define PG8_MMA(ai, bj, At, Bt) do { __builtin_amdgcn_s_setprio(1); _Pragma("unroll") for (int m = 0; m < 4; ++m) _Pragma("unroll") for (int n = 0; n < 2; ++n) _Pragma("unroll") for (int k = 0; k < 2; ++k) \
        acc[ai][bj][m][n] = __builtin_amdgcn_mfma_f32_16x16x32_bf16(Bt[n][k], At[m][k], acc[ai][bj][m][n], 0, 0, 0); __builtin_amdgcn_s_setprio(0); } while (0)
#define PG8_WAIT_V(n) asm volatile("s_waitcnt vmcnt(" #n ")" ::: "memory")
#define PG8_WAIT_L(n) asm volatile("s_waitcnt lgkmcnt(" #n ")" ::: "memory")
#define PG8_BAR __builtin_amdgcn_s_barrier()
#define PG8_SCHED __builtin_amdgcn_sched_barrier(0)
    Unit cur, nxt; int ui = 0;
    if (!S.next(0, cur)) return;
    f32x4 acc[2][2][4][2];
#pragma unroll
    for (int a = 0; a < 2; ++a)
#pragma unroll
        for (int b = 0; b < 2; ++b)
#pragma unroll
            for (int m = 0; m < 4; ++m)
#pragma unroll
                for (int n = 0; n < 2; ++n) acc[a][b][m][n] = (f32x4){0.f, 0.f, 0.f, 0.f};
    bf16x8 At[4][2], B0[2][2], B1[2][2];
    const char* cA = (const char*)g.A + (size_t)cur.pm * tstep; const char* cB = (const char*)g.Bt + (size_t)cur.pn * tstep;
    S.a_ready(cur);
    if constexpr (SP2) {
        PG8_STAGE(PG8_SB(0, 0), cB, voffB); PG8_STAGE(PG8_SB(0, 1), cB + hstep, voffB); PG8_STAGE(PG8_SA(0, 0), cA, voffA); PG8_STAGE(PG8_SA(0, 1), cA + hstep, voffA);
        if (wr == 1) PG8_BAR;
        PG8_WAIT_V(2); PG8_BAR;
        PG8_STAGE(PG8_SB(1, 0), cB + kstep, voffB); PG8_STAGE(PG8_SA(1, 0), cA + kstep, voffA); PG8_STAGE(PG8_SB(1, 1), cB + hstep + kstep, voffB);
        PG8_WAIT_V(6); PG8_BAR;
    } else {
        PG8_STAGE(PG8_SB(0, 0), cB, voffB); PG8_STAGE(PG8_SA(0, 0), cA, voffA); PG8_STAGE(PG8_SB(0, 1), cB + hstep, voffB); PG8_STAGE(PG8_SA(0, 1), cA + hstep, voffA);
        if (wr == 1) PG8_BAR;
        PG8_WAIT_V(4); PG8_BAR;
        PG8_STAGE(PG8_SB(1, 0), cB + kstep, voffB); PG8_STAGE(PG8_SA(1, 0), cA + kstep, voffA); PG8_STAGE(PG8_SB(1, 1), cB + hstep + kstep, voffB);
        PG8_WAIT_V(6); PG8_BAR;
    }
    for (;;) {
        const bool has_next = S.next(ui + 1, nxt);
        const char* nA = has_next ? (const char*)g.A + (size_t)nxt.pm * tstep : cA; const char* nB = has_next ? (const char*)g.Bt + (size_t)nxt.pn * tstep : cB;
        for (int t = 0; t < nt; t += 2) {
            const bool last = (t == nt - 2);
            const char* a1 = cA + (size_t)(t + 1) * kstep;
            const char* a2 = last ? nA : cA + (size_t)(t + 2) * kstep; const char* b2 = last ? nB : cB + (size_t)(t + 2) * kstep;
            const char* a3 = a2 + kstep; const char* b3 = b2 + kstep;
            if (last && has_next) S.a_ready(nxt);
            if constexpr (SP2) {
            PG8_LDB(B0, 0, 0); PG8_LDB(B1, 0, 1); PG8_SCHED; PG8_LDA(At, 0, 0); PG8_STAGE(PG8_SA(1, 1), a1 + hstep, voffA);
            PG8_WAIT_V(8); PG8_WAIT_L(0); PG8_BAR; PG8_MMA(0, 0, At, B0); PG8_MMA(0, 1, At, B1); PG8_BAR; PG8_SCHED;
            PG8_LDA(At, 0, 1); PG8_STAGE(PG8_SB(0, 0), b2, voffB); PG8_STAGE(PG8_SB(0, 1), b2 + hstep, voffB); PG8_STAGE(PG8_SA(0, 0), a2, voffA);
            PG8_WAIT_V(8); PG8_WAIT_L(0); PG8_BAR; PG8_MMA(1, 0, At, B0); PG8_MMA(1, 1, At, B1); PG8_BAR; PG8_SCHED;
            PG8_LDB(B0, 1, 0); PG8_LDB(B1, 1, 1); PG8_SCHED; PG8_LDA(At, 1, 0); PG8_STAGE(PG8_SA(0, 1), a2 + hstep, voffA);
            PG8_WAIT_V(8); PG8_WAIT_L(0); PG8_BAR; PG8_MMA(0, 0, At, B0); PG8_MMA(0, 1, At, B1); PG8_BAR; PG8_SCHED;
            PG8_LDA(At, 1, 1); PG8_STAGE(PG8_SB(1, 0), b3, voffB); PG8_STAGE(PG8_SB(1, 1), b3 + hstep, voffB); PG8_STAGE(PG8_SA(1, 0), a3, voffA);
            PG8_WAIT_V(8); PG8_WAIT_L(0); PG8_BAR; PG8_MMA(1, 0, At, B0); PG8_MMA(1, 1, At, B1); PG8_BAR; PG8_SCHED;
            } else {
            PG8_LDB(B0, 0, 0); PG8_SCHED; PG8_LDA(At, 0, 0); PG8_STAGE(PG8_SA(1, 1), a1 + hstep, voffA);
            PG8_WAIT_L(8); PG8_BAR; PG8_WAIT_L(0); PG8_MMA(0, 0, At, B0); PG8_BAR; PG8_SCHED;
            PG8_LDB(B1, 0, 1); PG8_STAGE(PG8_SB(0, 0), b2, voffB);
            PG8_BAR; PG8_WAIT_L(0); PG8_MMA(0, 1, At, B1); PG8_BAR;
            PG8_LDA(At, 0, 1); PG8_STAGE(PG8_SA(0, 0), a2, voffA);
            PG8_BAR; PG8_WAIT_L(0); PG8_MMA(1, 0, At, B0); PG8_BAR; PG8_SCHED;
            PG8_STAGE(PG8_SB(0, 1), b2 + hstep, voffB);
            PG8_WAIT_V(6); PG8_BAR; PG8_MMA(1, 1, At, B1); PG8_BAR;
            PG8_LDB(B0, 1, 0); PG8_SCHED; PG8_LDA(At, 1, 0); PG8_STAGE(PG8_SA(0, 1), a2 + hstep, voffA);
            PG8_WAIT_L(8); PG8_BAR; PG8_WAIT_L(0); PG8_MMA(0, 0, At, B0); PG8_BAR; PG8_SCHED;
            PG8_LDB(B1, 1, 1); PG8_STAGE(PG8_SB(1, 0), b3, voffB);
            PG8_BAR; PG8_WAIT_L(0); PG8_MMA(0, 1, At, B1); PG8_BAR;
            PG8_LDA(At, 1, 1); PG8_STAGE(PG8_SA(1, 0), a3, voffA);
            PG8_BAR; PG8_WAIT_L(0); PG8_MMA(1, 0, At, B0); PG8_BAR; PG8_SCHED;
            PG8_STAGE(PG8_SB(1, 1), b3 + hstep, voffB);
            PG8_WAIT_V(6); PG8_BAR; PG8_MMA(1, 1, At, B1); PG8_BAR;
            }
        }
        if constexpr (ALIGN_EPI) { if (wr == 0) PG8_BAR; }
        if constexpr (!Epi::AFTER_DRAIN) { E(acc, cur, wr, wc, fr, fq); S.done(cur); }
        if (!has_next) break;
#pragma unroll
        for (int a = 0; a < 2; ++a)
#pragma unroll
            for (int b = 0; b < 2; ++b)
#pragma unroll
                for (int m = 0; m < 4; ++m)
#pragma unroll
                    for (int n = 0; n < 2; ++n) acc[a][b][m][n] = (f32x4){0.f, 0.f, 0.f, 0.f};
        cur = nxt; cA = nA; cB = nB; ++ui;
        if constexpr (ALIGN_EPI) { if (wr == 1) PG8_BAR; }
    }
    PG8_WAIT_V(0);
    if constexpr (!ALIGN_EPI) { if (wr == 0) PG8_BAR; }
    PG8_BAR;
    if constexpr (Epi::AFTER_DRAIN) { E.fused(acc, cur, wr, wc, fr, fq, lds, wid, lane); S.done(cur); }
#undef PG8_SA
#undef PG8_SB
#undef PG8_STAGE
#undef PG8_LDA
#undef PG8_LDB
#undef PG8_MMA
#undef PG8_WAIT_V
#undef PG8_WAIT_L
#undef PG8_BAR
#undef PG8_SCHED
}
}
namespace fox {
constexpr int D = 128;
constexpr float SCALE = 0.08838834764831845f;
constexpr float THR = 8.f;
constexpr int NW = 8, QBLK = 32, KVBLK = 64, QB = NW * QBLK;
constexpr int SHM_V = KVBLK * D * 2, SHM_K = KVBLK * D * 2;
constexpr int LDS_BYTES = 2 * SHM_V + 2 * SHM_K + NW * 64 * 4;
typedef unsigned short bf16;
typedef short bf16x8 __attribute__((ext_vector_type(8)));
typedef short s16x4 __attribute__((ext_vector_type(4)));
typedef float f32x16 __attribute__((ext_vector_type(16)));
typedef float f32x4 __attribute__((ext_vector_type(4)));
typedef unsigned u32x4 __attribute__((ext_vector_type(4)));

#define KSWZ(row, colB) ((row) * 256 + ((colB) ^ (((row) & 7) << 4)))
#define SBAR() __builtin_amdgcn_sched_barrier(0)
__device__ __forceinline__ int v_st(int k, int c) { const int kk = (k & ~0xC) | ((k & 4) << 1) | ((k & 8) >> 1); return ((kk >> 3) * 4 + (c >> 5)) * 512 + ((kk & 7) * 32 + (c & 31)) * 2; }
__device__ __forceinline__ int v_rd_base(int lane) { return ((lane & 3) << 3) | (((lane >> 2) & 3) << 6) | (((lane >> 4) & 1) << 5) | (((lane >> 5) & 1) << 8); }
constexpr int v_rd_off(int d0, int ks, int half) { return d0 * 512 + ks * 4096 + half * 2048; }
__device__ __forceinline__ int crow(int r, int hi) { return (r & 3) + 8 * (r >> 2) + 4 * hi; }
__device__ __forceinline__ unsigned cvtpk(float lo, float hi) { unsigned r; asm volatile("v_cvt_pk_bf16_f32 %0, %1, %2" : "=v"(r) : "v"(lo), "v"(hi)); return r; }
__device__ __forceinline__ bf16x8 load8(const bf16* p) { return *reinterpret_cast<const bf16x8*>(p); }
__device__ __forceinline__ void mask_tile(f32x16& p0, f32x16& p1, int dq, unsigned W) {
    const float NEG = -__builtin_inff();
#pragma unroll
    for (int r = 0; r < 16; ++r) {
        const int c = (r & 3) + 8 * (r >> 2);
        if ((unsigned)(dq - c) >= W) p0[r] = NEG;
        if ((unsigned)(dq - c - 32) >= W) p1[r] = NEG;
    }
}
__device__ __forceinline__ void partialSM(f32x16& p0, f32x16& p1, float& m_reg, float& mn, float& alpha) {
    float pmax = p0[0]; for (int r = 1; r < 16; ++r) pmax = fmaxf(pmax, p0[r]); for (int r = 0; r < 16; ++r) pmax = fmaxf(pmax, p1[r]);
    { auto rr = __builtin_amdgcn_permlane32_swap(__float_as_uint(pmax), __float_as_uint(pmax), false, false);
      pmax = fmaxf(__uint_as_float(rr[0]), __uint_as_float(rr[1])); }
    constexpr float C2 = 1.4426950408889634f * SCALE;
    if (__builtin_expect(__all((pmax - m_reg) * SCALE <= THR), 1)) { mn = m_reg; alpha = 1.f; }
    else { mn = fmaxf(m_reg, pmax); alpha = __builtin_amdgcn_exp2f((m_reg - mn) * C2); m_reg = mn; }
    const float mnL = -mn * C2;
    for (int r = 0; r < 16; ++r) p0[r] = fmaf(p0[r], C2, mnL); for (int r = 0; r < 16; ++r) p1[r] = fmaf(p1[r], C2, mnL);
    for (int r = 0; r < 16; ++r) p0[r] = __builtin_amdgcn_exp2f(p0[r]);
}
__device__ __forceinline__ void finishSM(f32x16& p0, f32x16& p1, float alpha, float& l_reg, bf16x8& pa0, bf16x8& pa1, bf16x8& pa2, bf16x8& pa3) {
    for (int r = 0; r < 16; ++r) p1[r] = __builtin_amdgcn_exp2f(p1[r]);
    float ps = 0; for (int r = 0; r < 16; ++r) ps += p0[r]; for (int r = 0; r < 16; ++r) ps += p1[r];
    { auto rr = __builtin_amdgcn_permlane32_swap(__float_as_uint(ps), __float_as_uint(ps), false, false);
      ps = __uint_as_float(rr[0]) + __uint_as_float(rr[1]); }
    l_reg = l_reg * alpha + ps;
#define PK4(P, B_, OUT) do { unsigned a0 = cvtpk(P[B_+0], P[B_+1]), a1 = cvtpk(P[B_+2], P[B_+3]);                          \
        unsigned b0 = cvtpk(P[B_+4], P[B_+5]), b1 = cvtpk(P[B_+6], P[B_+7]);                                             \
        auto r0 = __builtin_amdgcn_permlane32_swap(a0, b0, false, false); auto r1 = __builtin_amdgcn_permlane32_swap(a1, b1, false, false); \
        u32x4 w = {r0[0], r1[0], r0[1], r1[1]}; OUT = *reinterpret_cast<bf16x8*>(&w); } while (0)
    PK4(p0, 0, pa0); PK4(p0, 8, pa1); PK4(p1, 0, pa2); PK4(p1, 8, pa3);
#undef PK4
}
template <int KB>
__device__ __forceinline__ void qkt(f32x16& p0, f32x16& p1, const char* K_lds, int r32, int hi, const bf16x8* qr, const float bias0, const float bias1) {
    p0 = f32x16{}; p1 = f32x16{};
    const char* kb[4];
#pragma unroll
    for (int dd = 0; dd < 4; ++dd) kb[dd] = K_lds + KB * SHM_K + KSWZ(r32, (dd * 16 + hi * 8) * 2);
#pragma unroll
    for (int d0 = 0; d0 < 8; ++d0) { const char* a = kb[d0 & 3] + (d0 >> 2) * 128;
        bf16x8 b0 = *reinterpret_cast<const bf16x8*>(a);
        bf16x8 b1 = *reinterpret_cast<const bf16x8*>(a + 32 * 256);
        p0 = __builtin_amdgcn_mfma_f32_32x32x16_bf16(b0, qr[d0], p0, 0, 0, 0);
        p1 = __builtin_amdgcn_mfma_f32_32x32x16_bf16(b1, qr[d0], p1, 0, 0, 0); }
    const float one = hi ? 0.f : 1.f;
    p0 = __builtin_amdgcn_mfma_f32_32x32x2f32(bias0, one, p0, 0, 0, 0);
    p1 = __builtin_amdgcn_mfma_f32_32x32x2f32(bias1, one, p1, 0, 0, 0);
}
template <int VB>
__device__ __forceinline__ void pv_tile(f32x16* o, int vb0, bf16x8 pa0, bf16x8 pa1, bf16x8 pa2, bf16x8 pa3) {
#define TRRD(dst, off) asm volatile("ds_read_b64_tr_b16 %0, %1 offset:%2" : "=&v"(dst) : "v"(vb0), "i"(off) : "memory")
#define PV_D0(d0) do { s16x4 l0, l1, l2, l3, h0, h1, h2, h3; constexpr int b_ = VB * SHM_V + v_rd_off(d0, 0, 0); \
        TRRD(l0, b_); TRRD(h0, b_ + 2048); TRRD(l1, b_ + 4096); TRRD(h1, b_ + 6144); TRRD(l2, b_ + 8192); TRRD(h2, b_ + 10240); TRRD(l3, b_ + 12288); TRRD(h3, b_ + 14336); \
        asm volatile("s_waitcnt lgkmcnt(0)" ::: "memory"); SBAR();   \
        o[d0] = __builtin_amdgcn_mfma_f32_32x32x16_bf16(pa0, (bf16x8){l0[0], l0[1], l0[2], l0[3], h0[0], h0[1], h0[2], h0[3]}, o[d0], 0, 0, 0);   \
        o[d0] = __builtin_amdgcn_mfma_f32_32x32x16_bf16(pa1, (bf16x8){l1[0], l1[1], l1[2], l1[3], h1[0], h1[1], h1[2], h1[3]}, o[d0], 0, 0, 0);   \
        o[d0] = __builtin_amdgcn_mfma_f32_32x32x16_bf16(pa2, (bf16x8){l2[0], l2[1], l2[2], l2[3], h2[0], h2[1], h2[2], h2[3]}, o[d0], 0, 0, 0);   \
        o[d0] = __builtin_amdgcn_mfma_f32_32x32x16_bf16(pa3, (bf16x8){l3[0], l3[1], l3[2], l3[3], h3[0], h3[1], h3[2], h3[3]}, o[d0], 0, 0, 0); } while (0)
    PV_D0(0); PV_D0(1); PV_D0(2); PV_D0(3);
#undef PV_D0
#undef TRRD
}
typedef float f32x2 __attribute__((ext_vector_type(2)));
struct BlockRef { const bf16* Q; const bf16* K; const bf16* V; bf16* O; const f32x2* CB; int P0; };
struct Seam { bf16x8 qr[8]; bf16x8 st_v0, st_v1, st_k0, st_k1; };
template <int LDQ, int LDO> struct Body {
#define ROW(p, k0, rr) ((p) + (unsigned)(((k0) + (rr)) * LDQ + sc))
#define VMW() asm volatile("s_waitcnt vmcnt(0)" ::: "memory")
#define VMWN(n) asm volatile("s_waitcnt vmcnt(%0)" :: "i"(n) : "memory")
#define SLOAD_H(Kp, Vp, k0) do { S.st_v0 = load8(ROW(Vp, k0, sr)); S.st_v1 = load8(ROW(Vp, k0, 32 + sr));              \
                         S.st_k0 = load8(ROW(Kp, k0, sr)); S.st_k1 = load8(ROW(Kp, k0, 32 + sr)); } while (0)
#define SWRITE_HK(bf) do { *(bf16x8*)(K_lds + (bf) * SHM_K + kws) = S.st_k0; *(bf16x8*)(K_lds + (bf) * SHM_K + kws + 32 * 256) = S.st_k1; } while (0)
#define SWRITE_HV(bf) do { *(bf16x8*)(V_lds + (bf) * SHM_V + vst0) = S.st_v0; *(bf16x8*)(V_lds + (bf) * SHM_V + vst1) = S.st_v1; } while (0)
#define SWRITE_H(bf) do { SWRITE_HV(bf); SWRITE_HK(bf); } while (0)
    static __device__ __forceinline__ void prime(const BlockRef& cur, char* lds, Seam& S) {
        const int tid = threadIdx.x, wid = __builtin_amdgcn_readfirstlane(tid >> 6), lane = tid & 63, r32 = lane & 31, hi = lane >> 5;
        const int sr = tid >> 4, sc = (tid & 15) * 8, kws = KSWZ(sr, sc * 2); char* K_lds = lds + 2 * SHM_V;
        const int kb0 = 0;
        for (int d0 = 0; d0 < 8; ++d0) S.qr[d0] = load8(cur.Q + (unsigned)((wid * QBLK + r32) * LDQ + d0 * 16 + hi * 8));
        SLOAD_H(cur.K, cur.V, kb0); VMW(); SWRITE_HK(0);
        __syncthreads();
    }
    static __device__ __forceinline__ void block(const BlockRef& cur, const BlockRef& nxt, int skv, char* lds, Seam& S) {
        const int tid = threadIdx.x, wid = __builtin_amdgcn_readfirstlane(tid >> 6), lane = tid & 63, r32 = lane & 31, hi = lane >> 5;
        const int W = skv;
        const int j_lo = 0;
        int j_hi = (cur.P0 + QB - 1) / KVBLK + 1; if (j_hi > skv / KVBLK) j_hi = skv / KVBLK;
        const int NT = j_hi - j_lo;
        const int kbn = 0;
        const int qlo = cur.P0 + wid * QBLK, qm = qlo + r32 - 4 * hi;
        char* V_lds = lds; char* K_lds = lds + 2 * SHM_V;
        float* ws = (float*)(lds + 2 * SHM_V + 2 * SHM_K) + wid * 64; float* li_l = ws, * al_l = ws + 32;
        float m_reg = -1e30f, l_reg = 0; f32x16 o[4] = {};
        const int sr = tid >> 4, sc = (tid & 15) * 8, vst0 = v_st(sr, sc), vst1 = v_st(32 + sr, sc), kws = KSWZ(sr, sc * 2);
        const int vb0 = (int)(uintptr_t)V_lds + v_rd_base(lane);
        const bf16* Kh = cur.K; const bf16* Vh = cur.V;
        const char* cbb = (const char*)cur.CB; const unsigned cbo = (unsigned)r32 * 8u;
        f32x2 bw = *(const f32x2*)(cbb + cbo);
#define BLOAD(t) do { bw = *(const f32x2*)(cbb + (cbo + (unsigned)((t) * 256))); } while (0)
#define RESC(a) do { if (__any((a) < 1.f)) { if (hi == 0) al_l[r32] = (a); asm volatile("s_waitcnt lgkmcnt(0)" ::: "memory");              \
                     for (int d_ = 0; d_ < 4; ++d_) for (int r = 0; r < 16; ++r) o[d_][r] *= al_l[crow(r, hi)]; } } while (0)
#define KBASE(t) ((j_lo + (t)) * KVBLK)
#define MASKT(P0_, P1_, t) do { const int kb_ = KBASE(t); if (kb_ + KVBLK - 1 > qlo || kb_ <= qlo + QBLK - 1 - W) mask_tile(P0_, P1_, qm - kb_, (unsigned)W); } while (0)
        constexpr int NQL = 8;
#define SEAM_K0() do { VMWN(NQL); SWRITE_HK(0); SBAR(); } while (0)
        f32x16 pA0, pA1, pB0, pB1; float mnA, mnB, alA, alB; bf16x8 pa0, pa1, pa2, pa3;
        SWRITE_HV(0); SBAR();
        if (NT > 1) { SLOAD_H(Kh, Vh, KBASE(1)); }
        SBAR(); qkt<0>(pA0, pA1, K_lds, r32, hi, S.qr, bw.x, bw.y); if (NT > 1) BLOAD(1);
        MASKT(pA0, pA1, 0); partialSM(pA0, pA1, m_reg, mnA, alA);
        if (NT > 1) { VMW(); SWRITE_H(1); }
        __syncthreads();
#define HALF_STEP(PX0, PX1, mnX, alX, PY0, PY1, alY, t, KB, VB, SB) do {                                                      \
        SBAR(); qkt<KB>(PX0, PX1, K_lds, r32, hi, S.qr, bw.x, bw.y); if ((t) + 1 < NT) BLOAD((t) + 1);                   \
        finishSM(PY0, PY1, alY, l_reg, pa0, pa1, pa2, pa3); SBAR();                                                           \
        if ((t) + 1 < NT) { SLOAD_H(Kh, Vh, KBASE((t) + 1)); SBAR(); }                                                       \
        pv_tile<VB>(o, vb0, pa0, pa1, pa2, pa3); MASKT(PX0, PX1, (t)); partialSM(PX0, PX1, m_reg, mnX, alX);                    \
        __syncthreads();                                                                                                      \
        if ((t) + 1 < NT) { VMW(); SWRITE_H(SB); }                                                                            \
        RESC(alX); __syncthreads(); } while (0)
        for (int t = 1; t + 1 < NT; t += 2) {
            HALF_STEP(pB0, pB1, mnB, alB, pA0, pA1, alA, t, 1, 0, 0);
            HALF_STEP(pA0, pA1, mnA, alA, pB0, pB1, alB, t + 1, 0, 1, 1);
        }
        const bool even = (NT & 1) == 0;
        if (even) { SBAR(); qkt<1>(pB0, pB1, K_lds, r32, hi, S.qr, bw.x, bw.y); SBAR(); }
        SLOAD_H(nxt.K, nxt.V, kbn); SBAR();
#pragma unroll
        for (int d0 = 0; d0 < 8; ++d0) S.qr[d0] = load8(nxt.Q + (unsigned)((wid * QBLK + r32) * LDQ + d0 * 16 + hi * 8));
        SBAR();
        finishSM(pA0, pA1, alA, l_reg, pa0, pa1, pa2, pa3); SBAR();
        pv_tile<0>(o, vb0, pa0, pa1, pa2, pa3);
        if (even) { MASKT(pB0, pB1, NT - 1); partialSM(pB0, pB1, m_reg, mnB, alB); __syncthreads(); RESC(alB);
            finishSM(pB0, pB1, alB, l_reg, pa0, pa1, pa2, pa3); SBAR(); pv_tile<1>(o, vb0, pa0, pa1, pa2, pa3); }
        SBAR(); SEAM_K0();
        if (hi == 0) li_l[r32] = l_reg; asm volatile("s_waitcnt lgkmcnt(0)" ::: "memory");
        float rli[16];
#pragma unroll
        for (int r = 0; r < 16; ++r) rli[r] = __builtin_amdgcn_rcpf(li_l[crow(r, hi)]);
        bf16* Ow = cur.O + (unsigned)((wid * QBLK) * LDO);
#pragma unroll
        for (int r = 0; r < 16; ++r) { const int orow = crow(r, hi);
#pragma unroll
            for (int d0 = 0; d0 < 4; ++d0) { const float v = o[d0][r] * rli[r];
                const float vn = __shfl_xor(v, 1);
                if ((r32 & 1) == 0) *(unsigned*)(Ow + (unsigned)(orow * LDO + d0 * 32 + r32)) = cvtpk(v, vn); } }
        __syncthreads();
#undef RESC
#undef KBASE
#undef MASKT
#undef SEAM_K0
#undef HALF_STEP
#undef BLOAD
    }
#undef ROW
#undef VMW
#undef VMWN
#undef SLOAD_H
#undef SWRITE_HK
#undef SWRITE_HV
#undef SWRITE_H
};
#undef KSWZ
#undef SBAR
}

constexpr int NWAVES = 8;
constexpr int DM = 4096, BATCH = 4, SEQ = 4096, M = BATCH * SEQ;
constexpr int NH = 16, HD = 128, HW = NH * HD;
constexpr int DFF = 11008, N_IN = 22576, CONVW = 3 * HW;
constexpr int LDP = 22528;
constexpr int PC_QA = 0, PC_KA = 2048, PC_VA = 4096, PC_ZA = 6144, PC_QB = 8192, PC_KB = 10240, PC_VB = 12288, PC_GA = 14336, PC_GB = 18432;
constexpr int SC_BETA = 8192, SC_ALPHA = 8208, SC_QB = 8224, SC_F = 14368, SC_GA = 14384;
constexpr int NSM = 48;
constexpr float EPS = 1e-6f;

constexpr size_t MiB = 1u << 20;
constexpr size_t WS_CTL = 0, CTL_ZERO_BYTES = 1 * MiB;
constexpr size_t WS_WIN = 1 * MiB;
constexpr size_t WS_WSM = 177 * MiB;
constexpr size_t WS_WA = 178 * MiB;
constexpr size_t WS_WB = 194 * MiB;
constexpr size_t WS_WO = 210 * MiB;
constexpr size_t WS_WGU = 242 * MiB;
constexpr size_t WS_WD = 414 * MiB;
constexpr size_t WS_XN = 500 * MiB;
constexpr size_t WS_OA = WS_XN, WS_OB = WS_XN + 64 * MiB;
constexpr size_t WS_SMALL = 628 * MiB;
constexpr size_t WS_CB = 631 * MiB;
constexpr size_t WS_P = 634 * MiB;
constexpr size_t WS_HN = WS_P, WS_ACT = WS_P + 128 * MiB;
constexpr size_t WS_MG = WS_WIN;
constexpr size_t WS_END = 1338 * MiB;
constexpr size_t WS_UF = WS_WIN;
constexpr size_t WS_EG = 512 * 1024;
constexpr int CW_BAR = 4096;
constexpr int CW_QUEUE = 8192;

constexpr int RING_OFF = 0, RING_BYTES = 155648;
constexpr int LDSCTL_OFF = RING_BYTES, MISC_OFF = LDSCTL_OFF + 320;
constexpr int LDS_BYTES = 157696;

#define GAS __attribute__((address_space(1)))
#define LAS __attribute__((address_space(3)))
typedef unsigned short bf16;
typedef unsigned v4u __attribute__((ext_vector_type(4)));
typedef unsigned v2u __attribute__((ext_vector_type(2)));
typedef float f32x4 __attribute__((ext_vector_type(4)));
typedef short bf16x8 __attribute__((ext_vector_type(8)));
#define LDS_WAIT() asm volatile("s_waitcnt lgkmcnt(0)" ::: "memory")
#define VM_WAIT() asm volatile("s_waitcnt vmcnt(0)" ::: "memory")
typedef float f32x2c __attribute__((ext_vector_type(2)));
typedef __bf16 bf16x2c __attribute__((ext_vector_type(2)));
__device__ __forceinline__ unsigned pk2(float lo, float hi) { const f32x2c v = {lo, hi}; return __builtin_bit_cast(unsigned, __builtin_convertvector(v, bf16x2c)); }
__device__ __forceinline__ unsigned f2bf(float f) { return pk2(f, f) & 0xffffu; }
__device__ __forceinline__ float bflo(unsigned w) { return __uint_as_float(w << 16); }
__device__ __forceinline__ float bfhi(unsigned w) { return __uint_as_float(w & 0xffff0000u); }
__device__ __forceinline__ float wave_sum(float v) {
#pragma unroll
    for (int o = 1; o < 64; o <<= 1) v += __shfl_xor(v, o);
    return v;
}
template <int CTRL> __device__ __forceinline__ float dppmov(float v) { return __builtin_bit_cast(float, __builtin_amdgcn_update_dpp(0, __builtin_bit_cast(int, v), CTRL, 0xF, 0xF, true)); }
__device__ __forceinline__ float sum8(float v) { v += dppmov<0xB1>(v); v += dppmov<0x4E>(v); v += dppmov<0x141>(v); return v; }
__device__ __forceinline__ float sum16(float v) { v = sum8(v); v += dppmov<0x140>(v); return v; }
__device__ __forceinline__ float silu_f(float x) { return x / (1.0f + __expf(-x)); }
__device__ __forceinline__ float silu_fast(float x) { return x * __builtin_amdgcn_rcpf(1.0f + __builtin_amdgcn_exp2f(-1.4426950408889634f * x)); }
__device__ __forceinline__ float sigm_f(float x) { return 1.0f / (1.0f + __expf(-x)); }
__device__ __forceinline__ float softplus_f(float x) { return fmaxf(x, 0.f) + log1pf(__expf(-fabsf(x))); }

#define XB_TMO      128
#define XB_XCNT(j)  (256  + 64 * (j))
#define XB_XSUB(j)  (1280 + 64 * (j))
#define XB_XGEN(j)  (2304 + 64 * (j))
#define XB_TOP      3328
#define XB_TOPGEN   3392
#define XCD_BAR_WORDS 3456
#define XB_SPIN_CAP (1u << 18)
__device__ __forceinline__ unsigned xb_ld(unsigned* p)              { return __hip_atomic_load(p, __ATOMIC_RELAXED, __HIP_MEMORY_SCOPE_AGENT); }
__device__ __forceinline__ unsigned xb_add(unsigned* p, unsigned v) { return __hip_atomic_fetch_add(p, v, __ATOMIC_RELAXED, __HIP_MEMORY_SCOPE_AGENT); }
__device__ __forceinline__ unsigned xb_xcc_id() { return (unsigned)__builtin_amdgcn_s_getreg((3 << 11) | 20) & 0xFu; }
#define XB_SPIN(cond, bar) do { unsigned _sp = 0; while (cond) { __builtin_amdgcn_s_sleep(1); \
    if ((++_sp & 255u) == 0u) { if (xb_ld(&(bar)[XB_TMO])) break; if (_sp > XB_SPIN_CAP) { atomicAdd(&(bar)[XB_TMO], 1u); break; } } } } while (0)
struct XcdBarrier { unsigned* bar; unsigned x; volatile LAS unsigned* st; };
__device__ __forceinline__ XcdBarrier xcd_barrier_post(unsigned* bar, volatile LAS unsigned* st) {
    XcdBarrier b; b.bar = bar; b.x = xb_xcc_id(); b.st = st;
    if (threadIdx.x == 0) (void)xb_add(&bar[XB_XCNT(b.x)], 1u);
    return b;
}
__device__ __forceinline__ void xcd_barrier_complete(unsigned* bar, unsigned x, unsigned& nloc, unsigned& nx) {
    const unsigned G = gridDim.x * gridDim.y * gridDim.z;
    unsigned sum, cnt, mine, sp = 0u;
    for (;;) {
        sum = 0u; cnt = 0u; mine = 0u;
#pragma unroll
        for (unsigned j = 0; j < 16; ++j) { const unsigned c = xb_ld(&bar[XB_XCNT(j)]); sum += c; cnt += (c > 0u) ? 1u : 0u; mine = (j == x) ? c : mine; }
        if (sum == G) break;
        __builtin_amdgcn_s_sleep(1);
        if ((++sp & 255u) == 0u) { if (xb_ld(&bar[XB_TMO])) break; if (sp > XB_SPIN_CAP) { atomicAdd(&bar[XB_TMO], 1u); break; } }
    }
    nloc = mine > 0u ? mine : 1u; nx = cnt > 0u ? cnt : 1u;
}
__device__ __forceinline__ void xcd_barrier(const XcdBarrier& b) {
    asm volatile("s_waitcnt vmcnt(0)" ::: "memory");
    __syncthreads();
    if (threadIdx.x == 0) {
        unsigned* bar = b.bar;
        __builtin_amdgcn_s_waitcnt(0);
        unsigned nloc = b.st[0], nx = b.st[1];
        if (nloc == 0u) { xcd_barrier_complete(bar, b.x, nloc, nx); b.st[0] = nloc; b.st[1] = nx; }
        const unsigned old = xb_add(&bar[XB_XSUB(b.x)], 1u);
        const unsigned gen = old / nloc;
        if (old + 1u == (gen + 1u) * nloc) {
            __builtin_amdgcn_fence(__ATOMIC_RELEASE, "agent");
            asm volatile("s_waitcnt vmcnt(0)" ::: "memory");
            const unsigned og = xb_add(&bar[XB_TOP], 1u);
            const unsigned tg = og / nx;
            if (og + 1u == (tg + 1u) * nx) xb_add(&bar[XB_TOPGEN], 1u);
            else XB_SPIN(xb_ld(&bar[XB_TOPGEN]) == tg, bar);
            __builtin_amdgcn_fence(__ATOMIC_ACQUIRE, "agent");
            xb_add(&bar[XB_XGEN(b.x)], 1u);
            asm volatile("s_waitcnt vmcnt(0)" ::: "memory");
        } else {
            XB_SPIN(xb_ld(&bar[XB_XGEN(b.x)]) == gen, bar);
            __builtin_amdgcn_fence(__ATOMIC_ACQUIRE, "agent");
            asm volatile("s_waitcnt vmcnt(0)" ::: "memory");
        }
    }
    __syncthreads();
}

__device__ __forceinline__ void transpose_items(const float* W, int K, int ldw, int src0, int ncols, int blk, int mul, int add, bf16* WT, LAS float* scr, int gw, int NGW, int lane) {
    const int nblk = ncols / 32, nitems = (K / 64) * nblk;
    for (int it = gw; it < nitems; it += NGW) {
        const int kb = it / nblk, nb = it - kb * nblk, k0 = 64 * kb, nl = 32 * nb;
        const int drow = (nl / blk) * mul + (nl % blk) + add;
        const float* src = W + (size_t)k0 * ldw + src0 + nl + (lane & 31);
        float tv[32];
#pragma unroll
        for (int i = 0; i < 32; ++i) tv[i] = src[(size_t)(2 * i + (lane >> 5)) * ldw];
#pragma unroll
        for (int i = 0; i < 32; ++i) scr[(2 * i + (lane >> 5)) * 33 + (lane & 31)] = tv[i];
        LDS_WAIT(); asm volatile("" ::: "memory");
        const int c = lane & 7;
#pragma unroll
        for (int j = 0; j < 4; ++j) { const int n = (lane >> 3) + 8 * j; const LAS float* s = scr + (8 * c) * 33 + n;
            v4u o; o.x = pk2(s[0 * 33], s[1 * 33]); o.y = pk2(s[2 * 33], s[3 * 33]); o.z = pk2(s[4 * 33], s[5 * 33]); o.w = pk2(s[6 * 33], s[7 * 33]);
            *(v4u*)(WT + (size_t)(drow + n) * K + k0 + 8 * c) = o; }
        LDS_WAIT(); asm volatile("" ::: "memory");
    }
}
__device__ __forceinline__ void transpose_items_pipe(const float* W, int K, int ldw, int src0, int ncols, int blk, int mul, int add, bf16* WT, LAS float* scr, int gw, int NGW, int lane) {
    const int nblk = ncols / 32, nitems = (K / 64) * nblk;
    int it = gw; if (it >= nitems) return;
    float tv[32];
    { const int kb = it / nblk, nb = it - kb * nblk; const float* src = W + (size_t)(64 * kb) * ldw + src0 + 32 * nb + (lane & 31);
#pragma unroll
      for (int i = 0; i < 32; ++i) tv[i] = src[(size_t)(2 * i + (lane >> 5)) * ldw]; }
    for (;;) {
        const int kb = it / nblk, nb = it - kb * nblk, k0 = 64 * kb, nl = 32 * nb;
        const int drow = (nl / blk) * mul + (nl % blk) + add;
        const int nit = it + NGW; const bool more = nit < nitems;
        float nv[32];
        { const int ld = more ? nit : it;
          const int kb2 = ld / nblk, nb2 = ld - kb2 * nblk; const float* src = W + (size_t)(64 * kb2) * ldw + src0 + 32 * nb2 + (lane & 31);
#pragma unroll
          for (int i = 0; i < 32; ++i) nv[i] = src[(size_t)(2 * i + (lane >> 5)) * ldw]; }
        asm volatile("" ::: "memory");
#pragma unroll
        for (int i = 0; i < 32; ++i) scr[(2 * i + (lane >> 5)) * 33 + (lane & 31)] = tv[i];
        LDS_WAIT(); asm volatile("" ::: "memory");
        const int c = lane & 7;
#pragma unroll
        for (int j = 0; j < 4; ++j) { const int n = (lane >> 3) + 8 * j; const LAS float* s = scr + (8 * c) * 33 + n;
            v4u o; o.x = pk2(s[0 * 33], s[1 * 33]); o.y = pk2(s[2 * 33], s[3 * 33]); o.z = pk2(s[4 * 33], s[5 * 33]); o.w = pk2(s[6 * 33], s[7 * 33]);
            *(v4u*)(WT + (size_t)(drow + n) * K + k0 + 8 * c) = o; }
        LDS_WAIT(); asm volatile("" ::: "memory");
        if (!more) break;
#pragma unroll
        for (int i = 0; i < 32; ++i) tv[i] = nv[i];
        it = nit;
    }
}
__device__ __forceinline__ void rms_row_to_bf16(const float* __restrict__ xrow, const float* __restrict__ w, bf16* __restrict__ orow, int lane) {
    const f32x4* xr = (const f32x4*)xrow + lane; const f32x4* wr = (const f32x4*)w + lane;
    f32x4 v[16], g[16]; float s = 0.f;
#pragma unroll
    for (int j = 0; j < 16; ++j) { v[j] = xr[64 * j]; g[j] = wr[64 * j]; }
#pragma unroll
    for (int j = 0; j < 16; ++j) s += (v[j].x * v[j].x + v[j].y * v[j].y) + (v[j].z * v[j].z + v[j].w * v[j].w);
    const float rstd = 1.0f / sqrtf(wave_sum(s) * (1.0f / DM) + EPS);
    unsigned long long* o8 = (unsigned long long*)orow + lane;
#pragma unroll
    for (int j = 0; j < 16; ++j)
        o8[64 * j] = (unsigned long long)pk2(v[j].x * rstd * g[j].x, v[j].y * rstd * g[j].y) | ((unsigned long long)pk2(v[j].z * rstd * g[j].z, v[j].w * rstd * g[j].w) << 32);
}
__device__ __forceinline__ void rms_row_bf16_to_bf16(const bf16* __restrict__ xrow, const float* __restrict__ w, bf16* __restrict__ orow, int lane) {
    const v4u* xr = (const v4u*)xrow + lane; const f32x4* wr = (const f32x4*)w + 2 * lane;
    v4u xv[8]; f32x4 g[16]; float s = 0.f;
#pragma unroll
    for (int j = 0; j < 8; ++j) { xv[j] = xr[64 * j]; g[2 * j] = wr[128 * j]; g[2 * j + 1] = wr[128 * j + 1]; }
    float v[64];
#pragma unroll
    for (int j = 0; j < 8; ++j) { v[8 * j] = bflo(xv[j].x); v[8 * j + 1] = bfhi(xv[j].x); v[8 * j + 2] = bflo(xv[j].y); v[8 * j + 3] = bfhi(xv[j].y);
        v[8 * j + 4] = bflo(xv[j].z); v[8 * j + 5] = bfhi(xv[j].z); v[8 * j + 6] = bflo(xv[j].w); v[8 * j + 7] = bfhi(xv[j].w); }
#pragma unroll
    for (int i = 0; i < 64; ++i) s += v[i] * v[i];
    const float rstd = 1.0f / sqrtf(wave_sum(s) * (1.0f / DM) + EPS);
    v4u* o = (v4u*)orow + lane;
#pragma unroll
    for (int j = 0; j < 8; ++j) { const f32x4 g0 = g[2 * j], g1 = g[2 * j + 1]; v4u ow;
        ow.x = pk2(v[8 * j] * rstd * g0.x, v[8 * j + 1] * rstd * g0.y); ow.y = pk2(v[8 * j + 2] * rstd * g0.z, v[8 * j + 3] * rstd * g0.w);
        ow.z = pk2(v[8 * j + 4] * rstd * g1.x, v[8 * j + 5] * rstd * g1.y); ow.w = pk2(v[8 * j + 6] * rstd * g1.z, v[8 * j + 7] * rstd * g1.w);
        o[64 * j] = ow; }
}
__device__ __forceinline__ void small_gemm(const bf16* XN, const bf16* WS, float* OUT, int gw, int NGW, int lane, int one_task = -1) {
    for (int task = (one_task >= 0 ? one_task : gw); task < M / 16; task += (one_task >= 0 ? M : NGW)) {
        const int m0 = task * 16;
        f32x4 acc[3] = {{0.f, 0.f, 0.f, 0.f}, {0.f, 0.f, 0.f, 0.f}, {0.f, 0.f, 0.f, 0.f}};
        const bf16* ap = XN + (size_t)(m0 + (lane & 15)) * DM + (lane >> 4) * 8;
        const bf16* bp = WS + (size_t)(lane & 15) * DM + (lane >> 4) * 8;
#pragma unroll 4
        for (int kt = 0; kt < DM / 32; ++kt) {
            const bf16x8 a = *(const bf16x8*)(ap + kt * 32);
#pragma unroll
            for (int nb = 0; nb < 3; ++nb) { const bf16x8 b = *(const bf16x8*)(bp + (size_t)nb * 16 * DM + kt * 32);
                acc[nb] = __builtin_amdgcn_mfma_f32_16x16x32_bf16(a, b, acc[nb], 0, 0, 0); }
        }
#pragma unroll
        for (int nb = 0; nb < 3; ++nb)
            *(f32x4*)(OUT + (size_t)(nb * 16 + (lane & 15)) * M + m0 + (lane >> 4) * 4) = acc[nb];
    }
}
__device__ __forceinline__ void fox_cumsum_wg(const float* SMALL, const float* b_f, unsigned* CB, int bh, LAS float* red) {
    const int tid = threadIdx.x, lane = tid & 63, wave = tid >> 6;
    const int b = bh / NH, h = bh % NH; const float bf = b_f[h];
    const f32x4* src = (const f32x4*)(SMALL + (size_t)(32 + h) * M + (size_t)b * SEQ + (size_t)tid * 8);
    const f32x4 v0 = src[0], v1 = src[1];
    float ls[8] = {v0.x, v0.y, v0.z, v0.w, v1.x, v1.y, v1.z, v1.w};
    float tot = 0.f;
#pragma unroll
    for (int i = 0; i < 8; ++i) { const float x = ls[i] + bf;
        tot += fminf(x, 0.f) - 0.6931471805599453f * __builtin_amdgcn_logf(1.0f + __builtin_amdgcn_exp2f(-1.4426950408889634f * fabsf(x))); ls[i] = tot; }
    float incl = tot;
#pragma unroll
    for (int o = 1; o < 64; o <<= 1) { const float t = __shfl_up(incl, o); if (lane >= o) incl += t; }
    if (lane == 63) red[wave] = incl;
    __syncthreads();
    float base = incl - tot;
#pragma unroll
    for (int w = 0; w < 7; ++w) base += (w < wave) ? red[w] : 0.f;
    float* dst = (float*)CB + ((size_t)bh * 64 + (tid >> 3)) * 32 * 2;
    const int p = (tid & 7) * 8;
#pragma unroll
    for (int i = 0; i < 8; ++i) dst[((p + i) & 31) * 2 + ((p + i) >> 5)] = -(base + ls[i]) * 11.313708498984761f;
}

constexpr int GREC = 57344;
constexpr int GR_W = 0, GR_Q = 16384, GR_K = 32768, GR_QK = 49152;
constexpr int RAWP = 784;
constexpr int G1_KB = 0, G1_QB = 17408, G1_RT = 34816, G1_AM = 71680, G1_SC = 89088, G1_RAW = 90112, G1_QKS = 143360;
#define GBAR() do { asm volatile("s_waitcnt lgkmcnt(0)" ::: "memory"); __builtin_amdgcn_s_barrier(); asm volatile("" ::: "memory"); } while (0)
__device__ __forceinline__ void g1_raw_offsets(unsigned (&roff)[7], int wave, int lane) {
#pragma unroll
    for (int i = 0; i < 7; ++i) { const int inst = i * 8 + wave; const int L = inst * 1024 + lane * 16; int row = L / RAWP; const int within = L - row * RAWP; if (row > 66) row = 66;
        int ten = within >> 8; const int chb = within & 255; if (ten > 2) ten = 2;
        roff[i] = (unsigned)(row * (LDP * 2) + ten * (HW * 2) + chb); }
}
__device__ __forceinline__ void g1_issue_raw(const char* base, const unsigned (&roff)[7], LAS unsigned char* raw, int wave) {
#pragma unroll
    for (int i = 0; i < 7; ++i) { const int inst = i * 8 + wave;
        if (inst < 52) __builtin_amdgcn_global_load_lds((const unsigned*)(base + roff[i]), (LAS unsigned*)(raw + inst * 1024), 16, 0, 0); }
}
__device__ __forceinline__ void gdn_prep_wg(const bf16* P, const float* SMALL, const float* conv_w, const float* a_log, const float* dt_bias,
                                            unsigned char* REC, bf16* UF, float* EG, LAS unsigned char* lds, int bh, int n0, int nch) {
    const int tid = threadIdx.x, lane = tid & 63, wave = __builtin_amdgcn_readfirstlane(tid >> 6);
    const int b = bh / NH, h = bh % NH;
    LAS unsigned char* kb = lds + G1_KB;
    LAS unsigned char* qb = lds + G1_QB;
    LAS unsigned char* RT = lds + G1_RT;
    LAS float* Amat = (LAS float*)(lds + G1_AM);
    LAS float* sc = (LAS float*)(lds + G1_SC);
    LAS unsigned char* raw = lds + G1_RAW;
    LAS unsigned char* QKs = lds + G1_QKS;
    LAS unsigned char* Tb = kb;
    LAS unsigned char* Ws = qb;
    const float Aexp = __expf(a_log[h]), dtb = dt_bias[h];
    float lg_b = 0.f, lg_a = 0.f;
    unsigned roff[7]; g1_raw_offsets(roff, wave, lane);
    const char* rbase = (const char*)P + (((size_t)b * SEQ + (size_t)n0 * 64) * LDP + h * HD) * 2 - (size_t)3 * LDP * 2;
    g1_issue_raw(rbase, roff, raw, wave);
    if (wave == 0) { const float* sm = SMALL + (size_t)b * SEQ + (size_t)n0 * 64 + lane; lg_b = sm[(size_t)h * M]; lg_a = sm[(size_t)(16 + h) * M]; }
    for (int k = 0; k < nch; ++k) {
        const int n = n0 + k, ci = bh * 64 + n;
        unsigned char* rec = REC + (size_t)ci * GREC;
        if (wave == 0) {
            const float be = sigm_f(lg_b);
            const float g = -Aexp * softplus_f(lg_a + dtb);
            float gc = g;
#pragma unroll
            for (int o = 1; o < 64; o <<= 1) { const float t = __shfl_up(gc, o); if (lane >= o) gc += t; }
            const float gl = __shfl(gc, 63);
            sc[lane] = gc; sc[64 + lane] = be; sc[128 + lane] = __expf(gc); sc[192 + lane] = __expf(gl - gc);
            if (lane == 63) EG[ci] = __expf(gl);
        }
        asm volatile("s_waitcnt vmcnt(0)" ::: "memory");
        GBAR();
        if (wave == 0 && k + 1 < nch) { const float* sm = SMALL + (size_t)b * SEQ + (size_t)(n + 1) * 64 + lane; lg_b = sm[(size_t)h * M]; lg_a = sm[(size_t)(16 + h) * M]; }
        {
            const int row = tid >> 3, cg = tid & 7, c0 = cg * 16;
            const int t = n * 64 + row;
            const float be = sc[64 + row], egc = sc[128 + row], egl = sc[192 + row];
#pragma unroll
            for (int ten = 0; ten < 3; ++ten) {
                const int pcol = ten * HW + h * HD + c0;
                float acc[16];
#pragma unroll
                for (int j = 0; j < 16; ++j) acc[j] = 0.f;
#pragma unroll
                for (int i = 0; i < 4; ++i) {
                    if (t - 3 + i >= 0) { const LAS unsigned char* src = raw + (row + i) * RAWP + ten * 256 + c0 * 2; const v4u x0 = *(const LAS v4u*)src, x1 = *(const LAS v4u*)(src + 16);
                        const float* w = conv_w + (size_t)i * CONVW + pcol;
                        const f32x4 w0 = *(const f32x4*)w, w1 = *(const f32x4*)(w + 4), w2 = *(const f32x4*)(w + 8), w3 = *(const f32x4*)(w + 12);
                        acc[0] += w0.x * bflo(x0.x); acc[1] += w0.y * bfhi(x0.x); acc[2] += w0.z * bflo(x0.y); acc[3] += w0.w * bfhi(x0.y);
                        acc[4] += w1.x * bflo(x0.z); acc[5] += w1.y * bfhi(x0.z); acc[6] += w1.z * bflo(x0.w); acc[7] += w1.w * bfhi(x0.w);
                        acc[8] += w2.x * bflo(x1.x); acc[9] += w2.y * bfhi(x1.x); acc[10] += w2.z * bflo(x1.y); acc[11] += w2.w * bfhi(x1.y);
                        acc[12] += w3.x * bflo(x1.z); acc[13] += w3.y * bfhi(x1.z); acc[14] += w3.z * bflo(x1.w); acc[15] += w3.w * bfhi(x1.w); } }
                float ss = 0.f;
#pragma unroll
                for (int j = 0; j < 16; ++j) { acc[j] = silu_fast(acc[j]); ss += acc[j] * acc[j]; }
                if (ten < 2) { ss = sum8(ss); const float s_ = (1.0f / sqrtf(ss + EPS)) * (ten == 0 ? 0.08838834764831845f : 1.0f);
#pragma unroll
                    for (int j = 0; j < 16; ++j) acc[j] *= s_; }
                if (ten == 0) {
                    v4u o0, o1; o0.x = pk2(acc[0], acc[1]); o0.y = pk2(acc[2], acc[3]); o0.z = pk2(acc[4], acc[5]); o0.w = pk2(acc[6], acc[7]);
                    o1.x = pk2(acc[8], acc[9]); o1.y = pk2(acc[10], acc[11]); o1.z = pk2(acc[12], acc[13]); o1.w = pk2(acc[14], acc[15]);
                    *(LAS v4u*)(qb + row * 272 + c0 * 2) = o0; *(LAS v4u*)(qb + row * 272 + c0 * 2 + 16) = o1;
                    unsigned char* dst = rec + GR_Q + ((row >> 4) * 4 + (c0 >> 5)) * 1024 + ((c0 >> 4) & 1) * 8;
#pragma unroll
                    for (int i = 0; i < 4; ++i) { v2u w; w.x = pk2(acc[4 * i] * egc, acc[4 * i + 1] * egc); w.y = pk2(acc[4 * i + 2] * egc, acc[4 * i + 3] * egc);
                        *(v2u*)(dst + ((row & 15) + 16 * i) * 16) = w; }
                } else if (ten == 1) {
                    v4u o0, o1; o0.x = pk2(acc[0], acc[1]); o0.y = pk2(acc[2], acc[3]); o0.z = pk2(acc[4], acc[5]); o0.w = pk2(acc[6], acc[7]);
                    o1.x = pk2(acc[8], acc[9]); o1.y = pk2(acc[10], acc[11]); o1.z = pk2(acc[12], acc[13]); o1.w = pk2(acc[14], acc[15]);
                    *(LAS v4u*)(kb + row * 272 + c0 * 2) = o0; *(LAS v4u*)(kb + row * 272 + c0 * 2 + 16) = o1;
                    const float bg = be * egc; const int off = row & 31, kq = (off & 15) >> 2, kj = (off & 3) + 4 * (off >> 4);
                    unsigned char* dst = rec + GR_K + ((c0 >> 4) * 2 + (row >> 5)) * 1024 + (16 * kq) * 16 + kj * 2;
#pragma unroll
                    for (int e = 0; e < 16; ++e) { *(LAS bf16*)(RT + (128 + c0 + e) * 144 + row * 2) = (bf16)f2bf(acc[e] * bg);
                        *(bf16*)(dst + e * 16) = (bf16)f2bf(acc[e] * egl); }
                } else {
#pragma unroll
                    for (int e = 0; e < 16; ++e) *(LAS bf16*)(RT + (c0 + e) * 144 + row * 2) = (bf16)f2bf(acc[e] * be);
                }
            }
        }
        GBAR();
        if (k + 1 < nch) g1_issue_raw(rbase + (size_t)(k + 1) * 64 * LDP * 2, roff, raw, wave);
        {
            const int fr = lane & 15, fq = lane >> 4;
#pragma unroll
            for (int i = 0; i < 4; ++i) {
                const int id = wave * 4 + i, mat = id >> 4, ct = (id >> 2) & 3, jt = id & 3;
                f32x4 acc = {0.f, 0.f, 0.f, 0.f};
                if (jt <= ct) {
                    const LAS unsigned char* ap = (mat ? qb : kb) + (16 * ct + fr) * 272 + fq * 16;
                    const LAS unsigned char* bp = kb + (16 * jt + fr) * 272 + fq * 16;
#pragma unroll
                    for (int ks = 0; ks < 4; ++ks) acc = __builtin_amdgcn_mfma_f32_16x16x32_bf16(*(const LAS bf16x8*)(ap + ks * 64), *(const LAS bf16x8*)(bp + ks * 64), acc, 0, 0, 0);
                }
                const int j = 16 * jt + fr; const float gj = sc[j];
#pragma unroll
                for (int r = 0; r < 4; ++r) { const int ii = 16 * ct + 4 * fq + r; const float dec = __expf(fminf(sc[ii] - gj, 0.f));
                    if (mat == 0) Amat[ii * 68 + (j & 7) * 8 + (j >> 3)] = (j < ii) ? acc[r] * sc[64 + ii] * dec : 0.f;
                    else { const float v = (j <= ii) ? acc[r] * dec : 0.f;
                        *(LAS bf16*)(QKs + (ct * 2 + (jt >> 1)) * 1024 + ((4 * fq + r) + 16 * (fr >> 2)) * 16 + ((fr & 3) + 4 * (jt & 1)) * 2) = (bf16)f2bf(v); } }
            }
        }
        GBAR();
        *(v4u*)(rec + GR_QK + tid * 16) = *(const LAS v4u*)(QKs + tid * 16);
        {
            const int cl = lane >> 3, part = lane & 7, c = wave * 8 + cl;
            float tc[8], pm[8];
#pragma unroll
            for (int m = 0; m < 8; ++m) { tc[m] = (m == (c >> 3) && part == (c & 7)) ? 1.f : 0.f; pm[m] = (part == m) ? 1.f : 0.f; }
            f32x4 na0 = *(const LAS f32x4*)(Amat + 1 * 68 + part * 8), na1 = (f32x4){0.f, 0.f, 0.f, 0.f};
#pragma unroll
            for (int i = 1; i < 64; ++i) {
                const f32x4 a0 = na0, a1 = na1;
                if (i + 1 < 64) { const LAS f32x4* ar = (const LAS f32x4*)(Amat + (i + 1) * 68 + part * 8); na0 = ar[0]; if (i + 1 > 32) na1 = ar[1]; }
                asm volatile("" ::: "memory");
                float s0 = a0.x * tc[0], s1 = a0.y * tc[1];
                if (i > 16) { s0 += a0.z * tc[2]; s1 += a0.w * tc[3]; } else if (i > 8) { s0 += a0.z * tc[2]; }
                if (i > 32) { s0 += a1.x * tc[4]; if (i > 40) s1 += a1.y * tc[5]; if (i > 48) s0 += a1.z * tc[6]; if (i > 56) s1 += a1.w * tc[7]; }
                const float s = sum8(s0 + s1);
                tc[i >> 3] = fmaf(-s, pm[i & 7], tc[i >> 3]);
            }
#pragma unroll
            for (int m = 0; m < 8; ++m) *(LAS bf16*)(Tb + (part + 8 * m) * 144 + c * 2) = (bf16)f2bf(tc[m]);
        }
        GBAR();
        {
            const int fr = lane & 15, fq = lane >> 4;
#pragma unroll
            for (int nt = 0; nt < 2; ++nt) {
                const int col = 32 * wave + 16 * nt + fr;
                f32x4 acc[4];
                const LAS unsigned char* bp = RT + col * 144 + fq * 16;
                const bf16x8 b0 = *(const LAS bf16x8*)bp, b1 = *(const LAS bf16x8*)(bp + 64);
#pragma unroll
                for (int ct = 0; ct < 4; ++ct) { const LAS unsigned char* ap = Tb + (16 * ct + fr) * 144 + fq * 16;
                    acc[ct] = (f32x4){0.f, 0.f, 0.f, 0.f};
                    acc[ct] = __builtin_amdgcn_mfma_f32_16x16x32_bf16(*(const LAS bf16x8*)ap, b0, acc[ct], 0, 0, 0);
                    acc[ct] = __builtin_amdgcn_mfma_f32_16x16x32_bf16(*(const LAS bf16x8*)(ap + 64), b1, acc[ct], 0, 0, 0); }
                if (wave < 4) {
                    v4u o0, o1; o0.x = pk2(acc[0][0], acc[0][1]); o0.y = pk2(acc[0][2], acc[0][3]); o0.z = pk2(acc[1][0], acc[1][1]); o0.w = pk2(acc[1][2], acc[1][3]);
                    o1.x = pk2(acc[2][0], acc[2][1]); o1.y = pk2(acc[2][2], acc[2][3]); o1.z = pk2(acc[3][0], acc[3][1]); o1.w = pk2(acc[3][2], acc[3][3]);
                    bf16* dst = UF + (((size_t)ci * 8 + (2 * wave + nt)) * 64 + lane) * 16;
                    *(v4u*)dst = o0; *(v4u*)(dst + 8) = o1;
                } else {
#pragma unroll
                    for (int ct = 0; ct < 4; ++ct)
#pragma unroll
                        for (int r = 0; r < 4; ++r)
                            *(LAS bf16*)(Ws + (ct * 4 + (wave - 4)) * 1024 + ((4 * fq + r) + 16 * (fr >> 2)) * 16 + ((fr & 3) + 4 * nt) * 2) = (bf16)f2bf(-acc[ct][r]);
                }
            }
        }
        GBAR();
        *(v4u*)(rec + GR_W + tid * 16) = *(const LAS v4u*)(Ws + tid * 16);
        *(v4u*)(rec + GR_W + 8192 + tid * 16) = *(const LAS v4u*)(Ws + 8192 + tid * 16);
    }
    asm volatile("s_waitcnt vmcnt(0) lgkmcnt(0)" ::: "memory");
    __syncthreads();
}
__device__ __forceinline__ bf16x8 pack_b(const f32x4 t0, const f32x4 t1) {
    v4u w; w.x = pk2(t0[0], t0[1]); w.y = pk2(t0[2], t0[3]); w.z = pk2(t1[0], t1[1]); w.w = pk2(t1[2], t1[3]);
    return *reinterpret_cast<bf16x8*>(&w);
}
constexpr int G2_OB = 2 * GREC, G2_OBP = 272;
__device__ __forceinline__ void gdn_scan8(const unsigned char* REC, const bf16* UF, const float* EG, bf16* OA, const bf16* P, const float* norm_w, LAS unsigned char* lds, int bh) {
    const int tid = threadIdx.x, lane = tid & 63, wave = __builtin_amdgcn_readfirstlane(tid >> 6);
    const int b = bh / NH, h = bh % NH, fr = lane & 15, fq = lane >> 4;
    const unsigned char* recb = REC + (size_t)bh * 64 * GREC;
#define GSTAGE(nn, bufi) do { _Pragma("unroll") for (int i_ = 0; i_ < 7; ++i_) { const int p_ = wave + 8 * i_; \
        __builtin_amdgcn_global_load_lds((const unsigned*)(recb + (size_t)(nn) * GREC + p_ * 1024 + lane * 16), (LAS unsigned*)(lds + (bufi) * GREC + p_ * 1024), 16, 0, 0); } } while (0)
    f32x4 S[8];
#pragma unroll
    for (int i = 0; i < 8; ++i) S[i] = (f32x4){0.f, 0.f, 0.f, 0.f};
    const bf16* ufp = UF + (((size_t)bh * 64 * 8 + wave) * 64 + lane) * 16;
    float w8[8];
#pragma unroll
    for (int j = 0; j < 8; ++j) w8[j] = norm_w[fr * 8 + j];
    const bf16* zp = P + ((size_t)b * SEQ + 8 * wave + fq) * LDP + PC_ZA + h * HD + fr * 8;
    bf16* op = OA + ((size_t)b * SEQ + 8 * wave + fq) * HW + h * HD + fr * 8;
    v4u u0 = *(const v4u*)ufp, u1 = *(const v4u*)(ufp + 8); float eg = EG[bh * 64];
    v4u z0 = {0u, 0u, 0u, 0u}, z1 = {0u, 0u, 0u, 0u};
    GSTAGE(0, 0);
    asm volatile("s_waitcnt vmcnt(0)" ::: "memory");
    __syncthreads();
#define G2_NORM_OUT(nn) do { const LAS unsigned char* ob_ = lds + G2_OB + ((nn) & 1) * (64 * G2_OBP) + (8 * wave + fq) * G2_OBP + fr * 16; \
        _Pragma("unroll") for (int j_ = 0; j_ < 2; ++j_) { const v4u x_ = *(const LAS v4u*)(ob_ + j_ * 4 * G2_OBP); const v4u z_ = j_ ? z1 : z0; \
            float v_[8] = {bflo(x_.x), bfhi(x_.x), bflo(x_.y), bfhi(x_.y), bflo(x_.z), bfhi(x_.z), bflo(x_.w), bfhi(x_.w)}; \
            const float zz_[8] = {bflo(z_.x), bfhi(z_.x), bflo(z_.y), bfhi(z_.y), bflo(z_.z), bfhi(z_.z), bflo(z_.w), bfhi(z_.w)}; \
            float ss_ = 0.f; _Pragma("unroll") for (int e_ = 0; e_ < 8; ++e_) ss_ += v_[e_] * v_[e_]; \
            ss_ = sum16(ss_); const float rs_ = 1.0f / sqrtf(ss_ * (1.0f / HD) + EPS); \
            _Pragma("unroll") for (int e_ = 0; e_ < 8; ++e_) v_[e_] = v_[e_] * rs_ * w8[e_] * silu_f(zz_[e_]); \
            v4u o_; o_.x = pk2(v_[0], v_[1]); o_.y = pk2(v_[2], v_[3]); o_.z = pk2(v_[4], v_[5]); o_.w = pk2(v_[6], v_[7]); \
            *(v4u*)(op + ((size_t)(nn) * 64 + 4 * j_) * HW) = o_; } } while (0)
    for (int n = 0; n < 64; ++n) {
        if (n > 0) G2_NORM_OUT(n - 1);
        f32x4 Vn[4], O[4]; const float egc = eg;
        Vn[0] = (f32x4){bflo(u0.x), bfhi(u0.x), bflo(u0.y), bfhi(u0.y)}; Vn[1] = (f32x4){bflo(u0.z), bfhi(u0.z), bflo(u0.w), bfhi(u0.w)};
        Vn[2] = (f32x4){bflo(u1.x), bfhi(u1.x), bflo(u1.y), bfhi(u1.y)}; Vn[3] = (f32x4){bflo(u1.z), bfhi(u1.z), bflo(u1.w), bfhi(u1.w)};
        { const bf16* zq = zp + (size_t)n * 64 * LDP; z0 = *(const v4u*)zq; z1 = *(const v4u*)(zq + (size_t)4 * LDP); }
        if (n + 1 < 64) { const bf16* up = ufp + (size_t)(n + 1) * (8 * 64 * 16); u0 = *(const v4u*)up; u1 = *(const v4u*)(up + 8); eg = EG[bh * 64 + n + 1]; }
        __builtin_amdgcn_sched_barrier(0);
        if (n + 1 < 64) GSTAGE(n + 1, (n + 1) & 1);
        __builtin_amdgcn_sched_barrier(0);
        bf16x8 Sb[4];
#pragma unroll
        for (int ks = 0; ks < 4; ++ks) Sb[ks] = pack_b(S[2 * ks], S[2 * ks + 1]);
        const LAS unsigned char* base = lds + (n & 1) * GREC + lane * 16;
#pragma unroll
        for (int ct = 0; ct < 4; ++ct) { O[ct] = (f32x4){0.f, 0.f, 0.f, 0.f};
#pragma unroll
            for (int ks = 0; ks < 4; ++ks) {
                Vn[ct] = __builtin_amdgcn_mfma_f32_16x16x32_bf16(*(const LAS bf16x8*)(base + GR_W + (ct * 4 + ks) * 1024), Sb[ks], Vn[ct], 0, 0, 0);
                O[ct] = __builtin_amdgcn_mfma_f32_16x16x32_bf16(*(const LAS bf16x8*)(base + GR_Q + (ct * 4 + ks) * 1024), Sb[ks], O[ct], 0, 0, 0); } }
        bf16x8 Vb[2];
        Vb[0] = pack_b(Vn[0], Vn[1]); Vb[1] = pack_b(Vn[2], Vn[3]);
#pragma unroll
        for (int ct = 0; ct < 4; ++ct)
#pragma unroll
            for (int ks = 0; ks < 2; ++ks) O[ct] = __builtin_amdgcn_mfma_f32_16x16x32_bf16(*(const LAS bf16x8*)(base + GR_QK + (ct * 2 + ks) * 1024), Vb[ks], O[ct], 0, 0, 0);
#pragma unroll
        for (int dt = 0; dt < 8; ++dt) { S[dt] = S[dt] * egc;
#pragma unroll
            for (int ks = 0; ks < 2; ++ks) S[dt] = __builtin_amdgcn_mfma_f32_16x16x32_bf16(*(const LAS bf16x8*)(base + GR_K + (dt * 2 + ks) * 1024), Vb[ks], S[dt], 0, 0, 0); }
        { LAS unsigned char* ow = lds + G2_OB + (n & 1) * (64 * G2_OBP) + (4 * fq) * G2_OBP + (16 * wave + fr) * 2;
#pragma unroll
          for (int ct = 0; ct < 4; ++ct)
#pragma unroll
              for (int r = 0; r < 4; ++r) *(LAS bf16*)(ow + (16 * ct + r) * G2_OBP) = (bf16)f2bf(O[ct][r]); }
        asm volatile("s_waitcnt vmcnt(0)" ::: "memory");
        __syncthreads();
    }
    G2_NORM_OUT(63);
#undef G2_NORM_OUT
#undef GSTAGE
    __syncthreads();
}
__device__ __forceinline__ int fox_jlo(const unsigned* CB, int bh, int qb, float skipT, float be, int lane) {
    const float b0 = __builtin_bit_cast(float, __builtin_amdgcn_readfirstlane(__builtin_bit_cast(int, ((const float*)CB)[((size_t)bh * 64 + 4 * qb) * 64])));
    const unsigned long long m = __ballot((lane < 4 * qb) && (b0 - be > skipT));
    return __builtin_amdgcn_readfirstlane((int)__popcll(m));
}
__device__ __forceinline__ fox::BlockRef fox_mkref(bf16* P, bf16* OB, unsigned* CB, int bh, int qb, int jlo) {
    const int b = bh / NH, h = bh % NH;
    fox::BlockRef r; const size_t row0 = (size_t)b * SEQ, rowk = row0 + (size_t)jlo * fox::KVBLK;
    r.Q = P + (row0 + (size_t)qb * fox::QB) * LDP + PC_QB + h * HD; r.K = P + rowk * LDP + PC_KB + h * HD; r.V = P + rowk * LDP + PC_VB + h * HD;
    r.O = OB + (row0 + (size_t)qb * fox::QB) * HW + h * HD; r.CB = (const fox::f32x2*)CB + ((size_t)bh * 64 + jlo) * 32; r.P0 = qb * fox::QB - jlo * fox::KVBLK; return r;
}
#ifndef MK_N_LAUNCHES
#define MK_N_LAUNCHES 1
#endif
constexpr int N_PHASES = 10;
#ifndef REP_PHASE
#define REP_PHASE -1
#endif
struct Args { const float* in[17]; float* out; unsigned char* ws; int ph_lo, ph_hi; };
__global__ void __launch_bounds__(NWAVES * 64, 2) mk_fwd(Args args) {
    extern __shared__ __attribute__((aligned(16))) unsigned char lds_raw[];
    LAS unsigned char* lds = (LAS unsigned char*)lds_raw;
    volatile LAS unsigned* MISC = (volatile LAS unsigned*)(lds + MISC_OFF);
    const int tid = threadIdx.x, lane = tid & 63, wave = __builtin_amdgcn_readfirstlane(tid >> 6);
    const int G = gridDim.x, bx = blockIdx.x;
    const int vcu = (G % 8 == 0) ? (bx % 8) * (G / 8) + bx / 8 : bx;
    const int gw = vcu * NWAVES + wave, NGW = G * NWAVES;
    unsigned char* ws = args.ws;
    const float* x = args.in[0]; const float* norm_mix_w = args.in[1]; const float* w_in = args.in[2]; const float* conv_w = args.in[3];
    const float* a_log = args.in[4]; const float* dt_bias = args.in[5]; const float* gdn_norm_w = args.in[6]; const float* fox_b_f = args.in[7];
    const float* fox_qn = args.in[8]; const float* fox_kn = args.in[9]; const float* w_ba = args.in[10]; const float* w_bb = args.in[11];
    const float* w_out = args.in[12]; const float* norm_ffn_w = args.in[13]; const float* w_g = args.in[14]; const float* w_u = args.in[15]; const float* w_d = args.in[16];
    float* out = args.out;
    bf16* WIN = (bf16*)(ws + WS_WIN); bf16* WSM = (bf16*)(ws + WS_WSM); bf16* WA = (bf16*)(ws + WS_WA); bf16* WB = (bf16*)(ws + WS_WB); bf16* WO = (bf16*)(ws + WS_WO);
    bf16* WGU = (bf16*)(ws + WS_WGU); bf16* WD = (bf16*)(ws + WS_WD); bf16* XN = (bf16*)(ws + WS_XN); bf16* OA = (bf16*)(ws + WS_OA); bf16* OB = (bf16*)(ws + WS_OB);
    float* SMALL = (float*)(ws + WS_SMALL); unsigned* CB = (unsigned*)(ws + WS_CB); bf16* P = (bf16*)(ws + WS_P); bf16* HN = (bf16*)(ws + WS_HN); bf16* ACT = (bf16*)(ws + WS_ACT);
    bf16* HB = (bf16*)(ws + WS_XN);
    bf16* MG = (bf16*)(ws + WS_MG); bf16* UF = (bf16*)(ws + WS_UF); float* EGp = (float*)(ws + WS_EG);
    unsigned* ctl = (unsigned*)(ws + WS_CTL);

    for (int u = tid; u < (LDS_BYTES - LDSCTL_OFF) / 4; u += NWAVES * 64) ((LAS unsigned*)(lds + LDSCTL_OFF))[u] = 0u;
    __syncthreads();
    XcdBarrier bar; bar.bar = ctl + CW_BAR; bar.x = 0; bar.st = nullptr;
    const int lo = args.ph_lo, hi = args.ph_hi;
    if (hi - lo > 1) bar = xcd_barrier_post(ctl + CW_BAR, MISC + 8);
#ifndef PHASE_MASK
#define PHASE_MASK 0xFFFF
#endif
#define IN(k) (((PHASE_MASK >> (k)) & 1) && lo <= (k) && (k) < hi)
#define SEAM(k) do { if (IN(k) && IN((k) + 1)) xcd_barrier(bar); } while (0)

    const bool wd_late = (G == 256) && IN(0) && IN(8);
    const bool fused01 = (hi - lo > 1) && IN(0) && IN(1) && G == 256;
    if (IN(0)) {
        LAS float* scr = (LAS float*)(lds + RING_OFF + wave * 16384);
        for (int idx = (vcu * NWAVES * 64 + tid); idx < NSM * DM; idx += G * NWAVES * 64) { const int r = idx / DM, k = idx - r * DM;
            const int col = r < 16 ? SC_BETA + r : r < 32 ? SC_ALPHA + (r - 16) : SC_F + (r - 32);
            WSM[idx] = (bf16)f2bf(w_in[(size_t)k * N_IN + col]); }
        if (fused01) {
            xcd_barrier(bar);
            for (int j = 0; j < 8; ++j) { const int m = vcu * 64 + wave * 8 + j; rms_row_to_bf16(x + (size_t)m * DM, norm_mix_w, XN + (size_t)m * DM, lane); }
            asm volatile("s_waitcnt vmcnt(0)" ::: "memory"); __syncthreads();
            if (wave < 4) small_gemm(XN, WSM, SMALL, 0, 1, lane, vcu * 4 + wave);
        } else {
            for (int m = gw; m < M; m += NGW) rms_row_to_bf16(x + (size_t)m * DM, norm_mix_w, XN + (size_t)m * DM, lane);
        }
        transpose_items(w_in, DM, N_IN, 0, 8192, 1 << 30, 0, 0, WIN, scr, gw, NGW, lane);
        transpose_items(w_in, DM, N_IN, SC_QB, 6144, 1 << 30, 0, PC_QB, WIN, scr, gw, NGW, lane);
        transpose_items(w_in, DM, N_IN, SC_GA, 8192, 1 << 30, 0, PC_GA, WIN, scr, gw, NGW, lane);
        transpose_items(w_ba, HW, DM, 0, DM, 1 << 30, 0, 0, WA, scr, gw, NGW, lane);
        transpose_items(w_bb, HW, DM, 0, DM, 1 << 30, 0, 0, WB, scr, gw, NGW, lane);
        transpose_items(w_out, DM, DM, 0, DM, 1 << 30, 0, 0, WO, scr, gw, NGW, lane);
        transpose_items(w_g, DM, DFF, 0, DFF, 128, 256, 0, WGU, scr, gw, NGW, lane);
        transpose_items(w_u, DM, DFF, 0, DFF, 128, 256, 128, WGU, scr, gw, NGW, lane);
        if (!wd_late) transpose_items(w_d, DFF, DM, 0, DM, 1 << 30, 0, 0, WD, scr, gw, NGW, lane);
    }
    SEAM(0);
    if (IN(1)) {
        if (!fused01) small_gemm(XN, WSM, SMALL, gw, NGW, lane);
        pg8::Gemm g{XN, WIN, M, LDP, DM}; pg8::StaticOrder S; S.init(M, LDP, G, bx);
        pg8::EpiStoreBf16 E{P, LDP, fox_qn, fox_kn, (LAS float*)(lds + RING_OFF + 131072), PC_QB / 256, PC_KB / 256, PC_VB / 256, EPS};
        pg8::gemm_phase<pg8::EpiStoreBf16, pg8::StaticOrder, true, true>(lds + RING_OFF, g, S, E);
    }
    SEAM(1);
    if (IN(2)) {
        if (bx < BATCH * NH) fox_cumsum_wg(SMALL, fox_b_f, CB, bx, (LAS float*)(lds + RING_OFF));
        for (int idx = bx; idx < 4 * BATCH * NH; idx += G) gdn_prep_wg(P, SMALL, conv_w, a_log, dt_bias, (unsigned char*)out, UF, EGp, lds + RING_OFF, (idx >> 2) & 63, (idx & 3) * 16, 16);
    }
    SEAM(2);
    if (IN(3)) {
        typedef fox::Body<LDP, HW> FB;
        char* albs = (char*)lds_raw + RING_OFF;
        if (bx < BATCH * NH) gdn_scan8((const unsigned char*)out, UF, EGp, OA, P, gdn_norm_w, lds + RING_OFF, bx);
        float skipT;
        { float mq = fmaxf(fabsf(fox_qn[lane]), fabsf(fox_qn[64 + lane])), mk = fmaxf(fabsf(fox_kn[lane]), fabsf(fox_kn[64 + lane]));
#pragma unroll
          for (int o = 1; o < 64; o <<= 1) { mq = fmaxf(mq, __shfl_xor(mq, o)); mk = fmaxf(mk, __shfl_xor(mk, o)); }
          const float Bq = 11.3137085f * 1.02f * mq * mk;
          skipT = __builtin_bit_cast(float, __builtin_amdgcn_readfirstlane(__builtin_bit_cast(int, 11.3137085f * (92.9f + 2.0f * Bq + 3.0f)))); }
        constexpr int NITEMS = BATCH * NH * (SEQ / fox::QB);
        unsigned* qhead = ctl + CW_QUEUE;
#define FOX_FETCH(slot) do { if (tid == 0) MISC[12 + (slot)] = xb_add(qhead, 1u); } while (0)
#define FOX_REF(it) fox_mkref(P, OB, CB, (int)((it) & 63u), 15 - (int)((it) >> 6), fox_jlo(CB, (int)((it) & 63u), 15 - (int)((it) >> 6), skipT, ((const float*)CB)[((size_t)((it) & 63u) * 64 + lane) * 64 + 63], lane))
        FOX_FETCH(0); FOX_FETCH(1);
        __syncthreads();
        unsigned it0 = (unsigned)__builtin_amdgcn_readfirstlane((int)MISC[12]), it1 = (unsigned)__builtin_amdgcn_readfirstlane((int)MISC[13]);
        __syncthreads();
        if (it0 < (unsigned)NITEMS) {
            fox::BlockRef cur = FOX_REF(it0);
            fox::Seam Sm;
            FB::prime(cur, albs, Sm);
            for (;;) {
                const bool more = it1 < (unsigned)NITEMS;
                const fox::BlockRef nxt = more ? FOX_REF(it1) : cur;
                FB::block(cur, nxt, SEQ, albs, Sm);
                if (!more) break;
                FOX_FETCH(0);
                __syncthreads();
                cur = nxt; it1 = (unsigned)__builtin_amdgcn_readfirstlane((int)MISC[12]);
                __syncthreads();
            }
        }
#undef FOX_FETCH
#undef FOX_REF
    }
    SEAM(3);
    if (IN(4)) {
        pg8::Gemm g{OA, WA, M, DM, HW}; pg8::StaticOrder S; S.init(M, DM, G, bx);
        pg8::EpiBranch<true> E{MG, DM, P + PC_GA, LDP};
        pg8::gemm_phase<pg8::EpiBranch<true>, pg8::StaticOrder, true, true>(lds + RING_OFF, g, S, E);
    }
    if (IN(4) && IN(5)) { asm volatile("s_waitcnt vmcnt(0)" ::: "memory"); __syncthreads(); }
    if (IN(5)) {
        pg8::Gemm g{OB, WB, M, DM, HW}; pg8::StaticOrder S; S.init(M, DM, G, bx);
        pg8::EpiBranch<false> E{MG, DM, P + PC_GB, LDP};
        pg8::gemm_phase<pg8::EpiBranch<false>, pg8::StaticOrder, true, true>(lds + RING_OFF, g, S, E);
    }
    SEAM(5);
    if (IN(6)) {
        pg8::Gemm g{MG, WO, M, DM, DM}; pg8::StaticOrder S; S.init(M, DM, G, bx);
        pg8::EpiResidToBf16 E{x, HB, DM};
        pg8::gemm_phase<pg8::EpiResidToBf16, pg8::StaticOrder, true, true>(lds + RING_OFF, g, S, E);
    }
    SEAM(6);
    if (IN(7)) {
        for (int m = gw; m < M; m += NGW) rms_row_bf16_to_bf16(HB + (size_t)m * DM, norm_ffn_w, HN + (size_t)m * DM, lane);
    }
    SEAM(7);
    if (IN(8)) {
        pg8::Gemm g{HN, WGU, M, 2 * DFF, DM}; pg8::StaticOrder S; S.init(M, 2 * DFF, G, bx);
        pg8::EpiSwiglu E{ACT, DFF};
        pg8::gemm_phase<pg8::EpiSwiglu, pg8::StaticOrder, true, true>(lds + RING_OFF, g, S, E);
        if (wd_late && bx >= (M / 256) * (2 * DFF / 256) % 256) {
            LAS float* scr = (LAS float*)(lds + RING_OFF + wave * 16384);
            transpose_items_pipe(w_d, DFF, DM, 0, DM, 1 << 30, 0, 0, WD, scr, (bx - 128) * NWAVES + wave, 128 * NWAVES, lane);
        }
    }
    SEAM(8);
    if (IN(9)) {
        pg8::Gemm g{ACT, WD, M, DM, DFF}; pg8::StaticOrder S; S.init(M, DM, G, bx);
        pg8::EpiResidFromBf16 E{HB, out, DM};
        pg8::gemm_phase<pg8::EpiResidFromBf16, pg8::StaticOrder, true, true>(lds + RING_OFF, g, S, E);
    }
#undef IN
#undef SEAM
}

extern "C" void kernel_launch(void* const* d_in, const int* in_sizes, int n_in, void* d_out, int out_size, void* d_ws, size_t ws_size, hipStream_t stream) {
    static int grid = 0;
    if (grid == 0) {
        if (n_in != 17 || in_sizes[0] != M * DM || out_size != M * DM || ws_size < WS_END) {
            fprintf(stderr, "kernel_launch: unexpected shapes (n_in %d, in0 %d, out %d, ws %zu < %zu); nothing launched\n", n_in, n_in > 0 ? in_sizes[0] : -1, out_size, ws_size, (size_t)WS_END); grid = -1; return; }
        int dev = 0, cus = 0, per_cu = 0;
        if (hipGetDevice(&dev) != hipSuccess || hipDeviceGetAttribute(&cus, hipDeviceAttributeMultiprocessorCount, dev) != hipSuccess) { grid = -1; return; }
        if (hipFuncSetAttribute((const void*)mk_fwd, hipFuncAttributeMaxDynamicSharedMemorySize, LDS_BYTES) != hipSuccess) { fprintf(stderr, "kernel_launch: hipFuncSetAttribute failed\n"); grid = -1; return; }
        if (hipOccupancyMaxActiveBlocksPerMultiprocessor(&per_cu, (const void*)mk_fwd, NWAVES * 64, LDS_BYTES) != hipSuccess || per_cu < 1)
            fprintf(stderr, "kernel_launch: note: occupancy query reports %d workgroups per CU\n", per_cu);
        (void)hipGetLastError();
        grid = cus;
    }
    if (grid < 0) return;
    (void)hipMemsetAsync((char*)d_ws + WS_CTL, 0, CTL_ZERO_BYTES, stream);
    Args a{};
    for (int i = 0; i < 17; ++i) a.in[i] = (const float*)d_in[i];
    a.out = (float*)d_out; a.ws = (unsigned char*)d_ws;
#if MK_N_LAUNCHES == 1
    a.ph_lo = 0; a.ph_hi = N_PHASES;
    hipLaunchKernelGGL(mk_fwd, dim3(grid), dim3(NWAVES * 64), LDS_BYTES, stream, a);
#else
    for (int p = 0; p < N_PHASES; ++p) { a.ph_lo = p; a.ph_hi = p + 1;
        for (int rep = 0; rep < (p == REP_PHASE ? 2 : 1); ++rep)
        hipLaunchKernelGGL(mk_fwd, dim3(grid), dim3(NWAVES * 64), LDS_BYTES, stream, a); }
#endif
}
```

```cpp
#include <hip/hip_runtime.h>
#include <cstdio>
#include <cstdint>
namespace pg8 {
#define PG8_LAS __attribute__((address_space(3)))
typedef unsigned short bf16_t;
typedef short bf16x8 __attribute__((ext_vector_type(8)));
typedef float f32x4 __attribute__((ext_vector_type(4)));
typedef unsigned u32x4 __attribute__((ext_vector_type(4)));
constexpr int BM = 256, BK = 64, HALF = 128, HTB = HALF * BK * 2  , STAGE_BYTES = 8 * HTB, NXCD = 8, WGM = 4;

__host__ __device__ __forceinline__ int lds_byte(int r, int c) { const int st = (r >> 4) * 2 + (c >> 5), rr = r & 15, cc = c & 31, ob = rr * 64 + cc * 2; return st * 1024 + (ob ^ (((ob >> 9) & 1) << 5)); }
__host__ __device__ __forceinline__ void stage_rc(int b, int& R, int& C) { const int st = b / 1024, sb = b % 1024, swz = sb ^ (((sb >> 9) & 1) << 5); R = (st >> 1) * 16 + swz / 64; C = (st & 1) * 32 + (swz % 64) / 2; }
__host__ __device__ __forceinline__ int perm32(int rho) { const int n = rho >> 4, i = rho & 15; return 8 * (i >> 2) + 4 * n + (i & 3); }

struct Unit { int pm, pn; };
struct Gemm { const bf16_t* A; const bf16_t* Bt; int M, N, K; };

struct StaticOrder {
    int nM, nN, nwg, G, c;
    __host__ __device__ void init(int M, int N, int G_, int c_) { nM = M / BM; nN = N / BM; nwg = nM * nN; G = G_; c = c_; }
    __host__ __device__ bool next(int i, Unit& u) const {
        const long L = (long)i * G + c; if (L >= nwg) return false;
        int wgid = (int)L; { const int q = nwg / NXCD, r = nwg % NXCD, xcd = wgid % NXCD, off = wgid / NXCD; wgid = (xcd < r ? xcd * (q + 1) : r * (q + 1) + (xcd - r) * q) + off; }
        const int nig = WGM * nN, gid = wgid / nig, fm = gid * WGM, gsz = (nM - fm) < WGM ? (nM - fm) : WGM;
        u.pm = fm + ((wgid % nig) % gsz); u.pn = (wgid % nig) / gsz; return true;
    }
    __device__ __forceinline__ void a_ready(const Unit&) const {}
    __device__ __forceinline__ void done(const Unit&) const {}
};

__device__ __forceinline__ unsigned cvt_pk_bf16(float lo, float hi) { unsigned r; asm volatile("v_cvt_pk_bf16_f32 %0, %1, %2" : "=v"(r) : "v"(lo), "v"(hi)); return r; }
__device__ __forceinline__ float bf_lo(unsigned w) { return __uint_as_float(w << 16); }
__device__ __forceinline__ float bf_hi(unsigned w) { return __uint_as_float(w & 0xffff0000u); }
__device__ __forceinline__ float sigmoid_f(float x) { return __builtin_amdgcn_rcpf(1.0f + __builtin_amdgcn_exp2f(-1.4426950408889634f * x)); }

struct EpiStoreBf16 {
    static constexpr bool PERM = true, AFTER_DRAIN = false;
    bf16_t* O; int ldc; const float* wq; const float* wk; PG8_LAS float* part; int qn_lo, qn_mid, qn_hi; float eps;
    __device__ __forceinline__ void operator()(const f32x4 (&acc)[2][2][4][2], const Unit& u, int wr, int wc, int fr, int fq) const {
        const int row0 = u.pm * BM + wr * 64 + fr, col0 = u.pn * BM + wc * 32 + 8 * fq;
        if (u.pn >= qn_lo && u.pn < qn_hi) {
            const float* wp = (u.pn < qn_mid ? wq : wk) + wc * 32 + 8 * fq;
            const f32x4 w0 = *(const f32x4*)wp, w1 = *(const f32x4*)(wp + 4);
#pragma unroll
            for (int ai = 0; ai < 2; ++ai)
#pragma unroll
                for (int m = 0; m < 4; ++m)
#pragma unroll
                    for (int bj = 0; bj < 2; ++bj) { const f32x4 v0 = acc[ai][bj][m][0], v1 = acc[ai][bj][m][1];
                        float ss = v0[0] * v0[0] + v0[1] * v0[1] + v0[2] * v0[2] + v0[3] * v0[3] + v1[0] * v1[0] + v1[1] * v1[1] + v1[2] * v1[2] + v1[3] * v1[3];
                        ss += __shfl_xor(ss, 16); ss += __shfl_xor(ss, 32);
                        if (fq == 0) part[(ai * HALF + wr * 64 + m * 16 + fr) * 8 + bj * 4 + wc] = ss; }
            asm volatile("s_waitcnt lgkmcnt(0)" ::: "memory"); __builtin_amdgcn_s_barrier(); asm volatile("" ::: "memory");
#pragma unroll
            for (int ai = 0; ai < 2; ++ai)
#pragma unroll
                for (int m = 0; m < 4; ++m) { bf16_t* rowp = O + (size_t)(row0 + ai * HALF + m * 16) * ldc + col0;
#pragma unroll
                    for (int bj = 0; bj < 2; ++bj) { const f32x4 p = *(const PG8_LAS f32x4*)(part + (ai * HALF + wr * 64 + m * 16 + fr) * 8 + bj * 4);
                        const float rs = 1.0f / sqrtf((p[0] + p[1] + p[2] + p[3]) * (1.0f / 128.0f) + eps);
                        const f32x4 v0 = acc[ai][bj][m][0], v1 = acc[ai][bj][m][1];
                        u32x4 w; w.x = cvt_pk_bf16(v0[0] * rs * w0[0], v0[1] * rs * w0[1]); w.y = cvt_pk_bf16(v0[2] * rs * w0[2], v0[3] * rs * w0[3]);
                        w.z = cvt_pk_bf16(v1[0] * rs * w1[0], v1[1] * rs * w1[1]); w.w = cvt_pk_bf16(v1[2] * rs * w1[2], v1[3] * rs * w1[3]);
                        *(u32x4*)(rowp + bj * HALF) = w; } }
            return;
        }
#pragma unroll
        for (int ai = 0; ai < 2; ++ai)
#pragma unroll
            for (int m = 0; m < 4; ++m) { bf16_t* rowp = O + (size_t)(row0 + ai * HALF + m * 16) * ldc + col0;
#pragma unroll
                for (int bj = 0; bj < 2; ++bj) { const f32x4 v0 = acc[ai][bj][m][0], v1 = acc[ai][bj][m][1];
                    u32x4 w; w.x = cvt_pk_bf16(v0[0], v0[1]); w.y = cvt_pk_bf16(v0[2], v0[3]); w.z = cvt_pk_bf16(v1[0], v1[1]); w.w = cvt_pk_bf16(v1[2], v1[3]);
                    *(u32x4*)(rowp + bj * HALF) = w; } }
    }
};
template <bool FIRST> struct EpiBranch {
    static constexpr bool PERM = true, AFTER_DRAIN = false;
    bf16_t* MG; int ldm; const bf16_t* G; int ldg;
    __device__ __forceinline__ void operator()(const f32x4 (&acc)[2][2][4][2], const Unit& u, int wr, int wc, int fr, int fq) const {
        const int row0 = u.pm * BM + wr * 64 + fr, col0 = u.pn * BM + wc * 32 + 8 * fq;
#pragma unroll
        for (int ai = 0; ai < 2; ++ai) {
            u32x4 gl[4][2], pl[4][2];
#pragma unroll
            for (int m = 0; m < 4; ++m)
#pragma unroll
                for (int bj = 0; bj < 2; ++bj) { const size_t r = (size_t)(row0 + ai * HALF + m * 16); const int c = col0 + bj * HALF;
                    gl[m][bj] = *(const u32x4*)(G + r * ldg + c); if (!FIRST) pl[m][bj] = *(const u32x4*)(MG + r * ldm + c); }
#pragma unroll
            for (int m = 0; m < 4; ++m)
#pragma unroll
                for (int bj = 0; bj < 2; ++bj) { const size_t r = (size_t)(row0 + ai * HALF + m * 16); const int c = col0 + bj * HALF;
                    const u32x4 g = gl[m][bj]; const f32x4 a0 = acc[ai][bj][m][0], a1 = acc[ai][bj][m][1];
                    float v[8];
                    v[0] = a0[0] * sigmoid_f(bf_lo(g.x)); v[1] = a0[1] * sigmoid_f(bf_hi(g.x)); v[2] = a0[2] * sigmoid_f(bf_lo(g.y)); v[3] = a0[3] * sigmoid_f(bf_hi(g.y));
                    v[4] = a1[0] * sigmoid_f(bf_lo(g.z)); v[5] = a1[1] * sigmoid_f(bf_hi(g.z)); v[6] = a1[2] * sigmoid_f(bf_lo(g.w)); v[7] = a1[3] * sigmoid_f(bf_hi(g.w));
                    if (!FIRST) { const u32x4 p = pl[m][bj];
                        v[0] += bf_lo(p.x); v[1] += bf_hi(p.x); v[2] += bf_lo(p.y); v[3] += bf_hi(p.y); v[4] += bf_lo(p.z); v[5] += bf_hi(p.z); v[6] += bf_lo(p.w); v[7] += bf_hi(p.w); }
                    u32x4 w; w.x = cvt_pk_bf16(v[0], v[1]); w.y = cvt_pk_bf16(v[2], v[3]); w.z = cvt_pk_bf16(v[4], v[5]); w.w = cvt_pk_bf16(v[6], v[7]);
                    *(u32x4*)(MG + r * ldm + c) = w; }
        }
    }
};
struct EpiResidToBf16 {
    static constexpr bool PERM = true, AFTER_DRAIN = false;
    const float* X; bf16_t* HB; int ld;
    __device__ __forceinline__ void operator()(const f32x4 (&acc)[2][2][4][2], const Unit& u, int wr, int wc, int fr, int fq) const {
        const int row0 = u.pm * BM + wr * 64 + fr, col0 = u.pn * BM + wc * 32 + 8 * fq;
#pragma unroll
        for (int ai = 0; ai < 2; ++ai) {
            f32x4 xv[4][2][2];
#pragma unroll
            for (int m = 0; m < 4; ++m)
#pragma unroll
                for (int bj = 0; bj < 2; ++bj) { const size_t off = (size_t)(row0 + ai * HALF + m * 16) * ld + col0 + bj * HALF;
                    xv[m][bj][0] = *(const f32x4*)(X + off); xv[m][bj][1] = *(const f32x4*)(X + off + 4); }
#pragma unroll
            for (int m = 0; m < 4; ++m)
#pragma unroll
                for (int bj = 0; bj < 2; ++bj) { const size_t off = (size_t)(row0 + ai * HALF + m * 16) * ld + col0 + bj * HALF;
                    const f32x4 v0 = xv[m][bj][0] + acc[ai][bj][m][0], v1 = xv[m][bj][1] + acc[ai][bj][m][1];
                    u32x4 w; w.x = cvt_pk_bf16(v0[0], v0[1]); w.y = cvt_pk_bf16(v0[2], v0[3]); w.z = cvt_pk_bf16(v1[0], v1[1]); w.w = cvt_pk_bf16(v1[2], v1[3]);
                    *(u32x4*)(HB + off) = w; }
        }
    }
};
struct EpiResidFromBf16 {
    static constexpr bool PERM = false, AFTER_DRAIN = false;
    const bf16_t* HB; float* OUT; int ld;
    __device__ __forceinline__ void operator()(const f32x4 (&acc)[2][2][4][2], const Unit& u, int wr, int wc, int fr, int fq) const {
        const int row0 = u.pm * BM + wr * 64 + fr, col0 = u.pn * BM + wc * 32 + 4 * fq;
        typedef unsigned u32x2 __attribute__((ext_vector_type(2)));
        u32x2 h[2][4][2][2];
#pragma unroll
        for (int ai = 0; ai < 2; ++ai)
#pragma unroll
            for (int m = 0; m < 4; ++m)
#pragma unroll
                for (int bj = 0; bj < 2; ++bj)
#pragma unroll
                    for (int n = 0; n < 2; ++n) h[ai][m][bj][n] = *(const u32x2*)(HB + (size_t)(row0 + ai * HALF + m * 16) * ld + col0 + bj * HALF + n * 16);
#pragma unroll
        for (int ai = 0; ai < 2; ++ai)
#pragma unroll
            for (int m = 0; m < 4; ++m)
#pragma unroll
                for (int bj = 0; bj < 2; ++bj)
#pragma unroll
                    for (int n = 0; n < 2; ++n) { const u32x2 hh = h[ai][m][bj][n];
                        const f32x4 hv = {bf_lo(hh.x), bf_hi(hh.x), bf_lo(hh.y), bf_hi(hh.y)};
                        *(f32x4*)(OUT + (size_t)(row0 + ai * HALF + m * 16) * ld + col0 + bj * HALF + n * 16) = hv + acc[ai][bj][m][n]; }
    }
};
struct EpiSwiglu {
    static constexpr bool PERM = true, AFTER_DRAIN = false;
    bf16_t* ACT; int ldc;
    __device__ __forceinline__ void operator()(const f32x4 (&acc)[2][2][4][2], const Unit& u, int wr, int wc, int fr, int fq) const {
        const int row0 = u.pm * BM + wr * 64 + fr, col0 = u.pn * HALF + wc * 32 + 8 * fq;
#pragma unroll
        for (int ai = 0; ai < 2; ++ai)
#pragma unroll
            for (int m = 0; m < 4; ++m) { bf16_t* rowp = ACT + (size_t)(row0 + ai * HALF + m * 16) * ldc + col0;
                float v[8];
#pragma unroll
                for (int n = 0; n < 2; ++n)
#pragma unroll
                    for (int j = 0; j < 4; ++j) { const float g = acc[ai][0][m][n][j], up = acc[ai][1][m][n][j]; v[4 * n + j] = g * sigmoid_f(g) * up; }
                u32x4 w; w.x = cvt_pk_bf16(v[0], v[1]); w.y = cvt_pk_bf16(v[2], v[3]); w.z = cvt_pk_bf16(v[4], v[5]); w.w = cvt_pk_bf16(v[6], v[7]);
                *(u32x4*)rowp = w; }
    }
};

template <class Epi, class Sched, bool ALIGN_EPI = false, bool SP2 = false>
__device__ __forceinline__ void gemm_phase(PG8_LAS unsigned char* lds, const Gemm g, const Sched& S, const Epi& E) {
    const int tid = threadIdx.x, wid = __builtin_amdgcn_readfirstlane(tid >> 6), lane = tid & 63, wr = wid >> 2, wc = wid & 3, fr = lane & 15, fq = lane >> 4;
    const int K = g.K, nt = K / BK;
    unsigned voffA[2], voffB[2];
#pragma unroll
    for (int i = 0; i < 2; ++i) { int R, C; stage_rc(tid * 16 + i * 8192, R, C); const int Rb = Epi::PERM ? ((R & ~31) + perm32(R & 31)) : R;
        voffA[i] = (unsigned)(R * K + C) * 2u; voffB[i] = (unsigned)(Rb * K + C) * 2u; }
    const size_t kstep = (size_t)(BK * 2);
    const size_t hstep = (size_t)HALF * K * 2;
    const size_t tstep = 2 * hstep;
    const unsigned ldsw = (unsigned)wid * 1024u;
    const int aoff = lds_byte(wr * 64 + fr, fq * 8), boff = lds_byte(wc * 32 + fr, fq * 8);
#define PG8_SA(b, h) (((b) * 2 + (h)) * HTB)
#define PG8_SB(b, h) ((4 + (b) * 2 + (h)) * HTB)
#define PG8_STAGE(bufoff, gbase, voff) do { _Pragma("unroll") for (int _i = 0; _i < 2; ++_i) \
        __builtin_amdgcn_global_load_lds((const unsigned*)((const char*)(gbase) + (voff)[_i]), (PG8_LAS unsigned*)(lds + (bufoff) + ldsw + _i * 8192), 16, 0, 0); } while (0)
#define PG8_LDA(dst, b, h) do { _Pragma("unroll") for (int m = 0; m < 4; ++m) _Pragma("unroll") for (int k = 0; k < 2; ++k) dst[m][k] = *(const PG8_LAS bf16x8*)(lds + PG8_SA(b, h) + aoff + m * 2048 + k * 1024); } while (0)
#define PG8_LDB(dst, b, h) do { _Pragma("unroll") for (int n = 0; n < 2; ++n) _Pragma("unroll") for (int k = 0; k < 2; ++k) dst[n][k] = *(const PG8_LAS bf16x8*)(lds + PG8_SB(b, h) + boff + n * 2048 + k * 1024); } while (0)
#define PG8_MMA(ai, bj, At, Bt) do { __builtin_amdgcn_s_setprio(1); _Pragma("unroll") for (int m = 0; m < 4; ++m) _Pragma("unroll") for (int n = 0; n < 2; ++n) _Pragma("unroll") for (int k = 0; k < 2; ++k) \
        acc[ai][bj][m][n] = __builtin_amdgcn_mfma_f32_16x16x32_bf16(Bt[n][k], At[m][k], acc[ai][bj][m][n], 0, 0, 0); __builtin_amdgcn_s_setprio(0); } while (0)
#define PG8_WAIT_V(n) asm volatile("s_waitcnt vmcnt(" #n ")" ::: "memory")
#define PG8_WAIT_L(n) asm volatile("s_waitcnt lgkmcnt(" #n ")" ::: "memory")
#define PG8_BAR __builtin_amdgcn_s_barrier()
#define PG8_SCHED __builtin_amdgcn_sched_barrier(0)
    Unit cur, nxt; int ui = 0;
    if (!S.next(0, cur)) return;
    f32x4 acc[2][2][4][2];
#pragma unroll
    for (int a = 0; a < 2; ++a)
#pragma unroll
        for (int b = 0; b < 2; ++b)
#pragma unroll
            for (int m = 0; m < 4; ++m)
#pragma unroll
                for (int n = 0; n < 2; ++n) acc[a][b][m][n] = (f32x4){0.f, 0.f, 0.f, 0.f};
    bf16x8 At[4][2], B0[2][2], B1[2][2];
    const char* cA = (const char*)g.A + (size_t)cur.pm * tstep; const char* cB = (const char*)g.Bt + (size_t)cur.pn * tstep;
    S.a_ready(cur);
    if constexpr (SP2) {
        PG8_STAGE(PG8_SB(0, 0), cB, voffB); PG8_STAGE(PG8_SB(0, 1), cB + hstep, voffB); PG8_STAGE(PG8_SA(0, 0), cA, voffA); PG8_STAGE(PG8_SA(0, 1), cA + hstep, voffA);
        if (wr == 1) PG8_BAR;
        PG8_WAIT_V(2); PG8_BAR;
        PG8_STAGE(PG8_SB(1, 0), cB + kstep, voffB); PG8_STAGE(PG8_SA(1, 0), cA + kstep, voffA); PG8_STAGE(PG8_SB(1, 1), cB + hstep + kstep, voffB);
        PG8_WAIT_V(6); PG8_BAR;
    } else {
        PG8_STAGE(PG8_SB(0, 0), cB, voffB); PG8_STAGE(PG8_SA(0, 0), cA, voffA); PG8_STAGE(PG8_SB(0, 1), cB + hstep, voffB); PG8_STAGE(PG8_SA(0, 1), cA + hstep, voffA);
        if (wr == 1) PG8_BAR;
        PG8_WAIT_V(4); PG8_BAR;
        PG8_STAGE(PG8_SB(1, 0), cB + kstep, voffB); PG8_STAGE(PG8_SA(1, 0), cA + kstep, voffA); PG8_STAGE(PG8_SB(1, 1), cB + hstep + kstep, voffB);
        PG8_WAIT_V(6); PG8_BAR;
    }
    for (;;) {
        const bool has_next = S.next(ui + 1, nxt);
        const char* nA = has_next ? (const char*)g.A + (size_t)nxt.pm * tstep : cA; const char* nB = has_next ? (const char*)g.Bt + (size_t)nxt.pn * tstep : cB;
        for (int t = 0; t < nt; t += 2) {
            const bool last = (t == nt - 2);
            const char* a1 = cA + (size_t)(t + 1) * kstep;
            const char* a2 = last ? nA : cA + (size_t)(t + 2) * kstep; const char* b2 = last ? nB : cB + (size_t)(t + 2) * kstep;
            const char* a3 = a2 + kstep; const char* b3 = b2 + kstep;
            if (last && has_next) S.a_ready(nxt);
            if constexpr (SP2) {
            PG8_LDB(B0, 0, 0); PG8_LDB(B1, 0, 1); PG8_SCHED; PG8_LDA(At, 0, 0); PG8_STAGE(PG8_SA(1, 1), a1 + hstep, voffA);
            PG8_WAIT_V(8); PG8_WAIT_L(0); PG8_BAR; PG8_MMA(0, 0, At, B0); PG8_MMA(0, 1, At, B1); PG8_BAR; PG8_SCHED;
            PG8_LDA(At, 0, 1); PG8_STAGE(PG8_SB(0, 0), b2, voffB); PG8_STAGE(PG8_SB(0, 1), b2 + hstep, voffB); PG8_STAGE(PG8_SA(0, 0), a2, voffA);
            PG8_WAIT_V(8); PG8_WAIT_L(0); PG8_BAR; PG8_MMA(1, 0, At, B0); PG8_MMA(1, 1, At, B1); PG8_BAR; PG8_SCHED;
            PG8_LDB(B0, 1, 0); PG8_LDB(B1, 1, 1); PG8_SCHED; PG8_LDA(At, 1, 0); PG8_STAGE(PG8_SA(0, 1), a2 + hstep, voffA);
            PG8_WAIT_V(8); PG8_WAIT_L(0); PG8_BAR; PG8_MMA(0, 0, At, B0); PG8_MMA(0, 1, At, B1); PG8_BAR; PG8_SCHED;
            PG8_LDA(At, 1, 1); PG8_STAGE(PG8_SB(1, 0), b3, voffB); PG8_STAGE(PG8_SB(1, 1), b3 + hstep, voffB); PG8_STAGE(PG8_SA(1, 0), a3, voffA);
            PG8_WAIT_V(8); PG8_WAIT_L(0); PG8_BAR; PG8_MMA(1, 0, At, B0); PG8_MMA(1, 1, At, B1); PG8_BAR; PG8_SCHED;
            } else {
            PG8_LDB(B0, 0, 0); PG8_SCHED; PG8_LDA(At, 0, 0); PG8_STAGE(PG8_SA(1, 1), a1 + hstep, voffA);
            PG8_WAIT_L(8); PG8_BAR; PG8_WAIT_L(0); PG8_MMA(0, 0, At, B0); PG8_BAR; PG8_SCHED;
            PG8_LDB(B1, 0, 1); PG8_STAGE(PG8_SB(0, 0), b2, voffB);
            PG8_BAR; PG8_WAIT_L(0); PG8_MMA(0, 1, At, B1); PG8_BAR;
            PG8_LDA(At, 0, 1); PG8_STAGE(PG8_SA(0, 0), a2, voffA);
            PG8_BAR; PG8_WAIT_L(0); PG8_MMA(1, 0, At, B0); PG8_BAR; PG8_SCHED;
            PG8_STAGE(PG8_SB(0, 1), b2 + hstep, voffB);
            PG8_WAIT_V(6); PG8_BAR; PG8_MMA(1, 1, At, B1); PG8_BAR;
            PG8_LDB(B0, 1, 0); PG8_SCHED; PG8_LDA(At, 1, 0); PG8_STAGE(PG8_SA(0, 1), a2 + hstep, voffA);
            PG8_WAIT_L(8); PG8_BAR; PG8_WAIT_L(0); PG8_MMA(0, 0, At, B0); PG8_BAR; PG8_SCHED;
            PG8_LDB(B1, 1, 1); PG8_STAGE(PG8_SB(1, 0), b3, voffB);
            PG8_BAR; PG8_WAIT_L(0); PG8_MMA(0, 1, At, B1); PG8_BAR;
            PG8_LDA(At, 1, 1); PG8_STAGE(PG8_SA(1, 0), a3, voffA);
            PG8_BAR; PG8_WAIT_L(0); PG8_MMA(1, 0, At, B0); PG8_BAR; PG8_SCHED;
            PG8_STAGE(PG8_SB(1, 1), b3 + hstep, voffB);
            PG8_WAIT_V(6); PG8_BAR; PG8_MMA(1, 1, At, B1); PG8_BAR;
            }
        }
        if constexpr (ALIGN_EPI) { if (wr == 0) PG8_BAR; }
        if constexpr (!Epi::AFTER_DRAIN) { E(acc, cur, wr, wc, fr, fq); S.done(cur); }
        if (!has_next) break;
#pragma unroll
        for (int a = 0; a < 2; ++a)
#pragma unroll
            for (int b = 0; b < 2; ++b)
#pragma unroll
                for (int m = 0; m < 4; ++m)
#pragma unroll
                    for (int n = 0; n < 2; ++n) acc[a][b][m][n] = (f32x4){0.f, 0.f, 0.f, 0.f};
        cur = nxt; cA = nA; cB = nB; ++ui;
        if constexpr (ALIGN_EPI) { if (wr == 1) PG8_BAR; }
    }
    PG8_WAIT_V(0);
    if constexpr (!ALIGN_EPI) { if (wr == 0) PG8_BAR; }
    PG8_BAR;
    if constexpr (Epi::AFTER_DRAIN) { E.fused(acc, cur, wr, wc, fr, fq, lds, wid, lane); S.done(cur); }
#undef PG8_SA
#undef PG8_SB
#undef PG8_STAGE
#undef PG8_LDA
#undef PG8_LDB
#undef PG8_MMA
#undef PG8_WAIT_V
#undef PG8_WAIT_L
#undef PG8_BAR
#undef PG8_SCHED
}
}
namespace fox {
constexpr int D = 128;
constexpr float SCALE = 0.08838834764831845f;
constexpr float THR = 8.f;
constexpr int NW = 8, QBLK = 32, KVBLK = 64, QB = NW * QBLK;
constexpr int SHM_V = KVBLK * D * 2, SHM_K = KVBLK * D * 2;
constexpr int LDS_BYTES = 2 * SHM_V + 2 * SHM_K + NW * 64 * 4;
typedef unsigned short bf16;
typedef short bf16x8 __attribute__((ext_vector_type(8)));
typedef short s16x4 __attribute__((ext_vector_type(4)));
typedef float f32x16 __attribute__((ext_vector_type(16)));
typedef float f32x4 __attribute__((ext_vector_type(4)));
typedef unsigned u32x4 __attribute__((ext_vector_type(4)));

#define KSWZ(row, colB) ((row) * 256 + ((colB) ^ (((row) & 7) << 4)))
#define SBAR() __builtin_amdgcn_sched_barrier(0)
__device__ __forceinline__ int v_st(int k, int c) { const int kk = (k & ~0xC) | ((k & 4) << 1) | ((k & 8) >> 1); return ((kk >> 3) * 4 + (c >> 5)) * 512 + ((kk & 7) * 32 + (c & 31)) * 2; }
__device__ __forceinline__ int v_rd_base(int lane) { return ((lane & 3) << 3) | (((lane >> 2) & 3) << 6) | (((lane >> 4) & 1) << 5) | (((lane >> 5) & 1) << 8); }
constexpr int v_rd_off(int d0, int ks, int half) { return d0 * 512 + ks * 4096 + half * 2048; }
__device__ __forceinline__ int crow(int r, int hi) { return (r & 3) + 8 * (r >> 2) + 4 * hi; }
__device__ __forceinline__ unsigned cvtpk(float lo, float hi) { unsigned r; asm volatile("v_cvt_pk_bf16_f32 %0, %1, %2" : "=v"(r) : "v"(lo), "v"(hi)); return r; }
__device__ __forceinline__ bf16x8 load8(const bf16* p) { return *reinterpret_cast<const bf16x8*>(p); }
__device__ __forceinline__ void mask_tile(f32x16& p0, f32x16& p1, int dq, unsigned W) {
    const float NEG = -__builtin_inff();
#pragma unroll
    for (int r = 0; r < 16; ++r) {
        const int c = (r & 3) + 8 * (r >> 2);
        if ((unsigned)(dq - c) >= W) p0[r] = NEG;
        if ((unsigned)(dq - c - 32) >= W) p1[r] = NEG;
    }
}
__device__ __forceinline__ void partialSM(f32x16& p0, f32x16& p1, float& m_reg, float& mn, float& alpha) {
    float pmax = p0[0]; for (int r = 1; r < 16; ++r) pmax = fmaxf(pmax, p0[r]); for (int r = 0; r < 16; ++r) pmax = fmaxf(pmax, p1[r]);
    { auto rr = __builtin_amdgcn_permlane32_swap(__float_as_uint(pmax), __float_as_uint(pmax), false, false);
      pmax = fmaxf(__uint_as_float(rr[0]), __uint_as_float(rr[1])); }
    constexpr float C2 = 1.4426950408889634f * SCALE;
    if (__builtin_expect(__all((pmax - m_reg) * SCALE <= THR), 1)) { mn = m_reg; alpha = 1.f; }
    else { mn = fmaxf(m_reg, pmax); alpha = __builtin_amdgcn_exp2f((m_reg - mn) * C2); m_reg = mn; }
    const float mnL = -mn * C2;
    for (int r = 0; r < 16; ++r) p0[r] = fmaf(p0[r], C2, mnL); for (int r = 0; r < 16; ++r) p1[r] = fmaf(p1[r], C2, mnL);
    for (int r = 0; r < 16; ++r) p0[r] = __builtin_amdgcn_exp2f(p0[r]);
}
__device__ __forceinline__ void finishSM(f32x16& p0, f32x16& p1, float alpha, float& l_reg, bf16x8& pa0, bf16x8& pa1, bf16x8& pa2, bf16x8& pa3) {
    for (int r = 0; r < 16; ++r) p1[r] = __builtin_amdgcn_exp2f(p1[r]);
    float ps = 0; for (int r = 0; r < 16; ++r) ps += p0[r]; for (int r = 0; r < 16; ++r) ps += p1[r];
    { auto rr = __builtin_amdgcn_permlane32_swap(__float_as_uint(ps), __float_as_uint(ps), false, false);
      ps = __uint_as_float(rr[0]) + __uint_as_float(rr[1]); }
    l_reg = l_reg * alpha + ps;
#define PK4(P, B_, OUT) do { unsigned a0 = cvtpk(P[B_+0], P[B_+1]), a1 = cvtpk(P[B_+2], P[B_+3]);                          \
        unsigned b0 = cvtpk(P[B_+4], P[B_+5]), b1 = cvtpk(P[B_+6], P[B_+7]);                                             \
        auto r0 = __builtin_amdgcn_permlane32_swap(a0, b0, false, false); auto r1 = __builtin_amdgcn_permlane32_swap(a1, b1, false, false); \
        u32x4 w = {r0[0], r1[0], r0[1], r1[1]}; OUT = *reinterpret_cast<bf16x8*>(&w); } while (0)
    PK4(p0, 0, pa0); PK4(p0, 8, pa1); PK4(p1, 0, pa2); PK4(p1, 8, pa3);
#undef PK4
}
template <int KB>
__device__ __forceinline__ void qkt(f32x16& p0, f32x16& p1, const char* K_lds, int r32, int hi, const bf16x8* qr, const float bias0, const float bias1) {
    p0 = f32x16{}; p1 = f32x16{};
    const char* kb[4];
#pragma unroll
    for (int dd = 0; dd < 4; ++dd) kb[dd] = K_lds + KB * SHM_K + KSWZ(r32, (dd * 16 + hi * 8) * 2);
#pragma unroll
    for (int d0 = 0; d0 < 8; ++d0) { const char* a = kb[d0 & 3] + (d0 >> 2) * 128;
        bf16x8 b0 = *reinterpret_cast<const bf16x8*>(a);
        bf16x8 b1 = *reinterpret_cast<const bf16x8*>(a + 32 * 256);
        p0 = __builtin_amdgcn_mfma_f32_32x32x16_bf16(b0, qr[d0], p0, 0, 0, 0);
        p1 = __builtin_amdgcn_mfma_f32_32x32x16_bf16(b1, qr[d0], p1, 0, 0, 0); }
    const float one = hi ? 0.f : 1.f;
    p0 = __builtin_amdgcn_mfma_f32_32x32x2f32(bias0, one, p0, 0, 0, 0);
    p1 = __builtin_amdgcn_mfma_f32_32x32x2f32(bias1, one, p1, 0, 0, 0);
}
template <int VB>
__device__ __forceinline__ void pv_tile(f32x16* o, int vb0, bf16x8 pa0, bf16x8 pa1, bf16x8 pa2, bf16x8 pa3) {
#define TRRD(dst, off) asm volatile("ds_read_b64_tr_b16 %0, %1 offset:%2" : "=&v"(dst) : "v"(vb0), "i"(off) : "memory")
#define PV_D0(d0) do { s16x4 l0, l1, l2, l3, h0, h1, h2, h3; constexpr int b_ = VB * SHM_V + v_rd_off(d0, 0, 0); \
        TRRD(l0, b_); TRRD(h0, b_ + 2048); TRRD(l1, b_ + 4096); TRRD(h1, b_ + 6144); TRRD(l2, b_ + 8192); TRRD(h2, b_ + 10240); TRRD(l3, b_ + 12288); TRRD(h3, b_ + 14336); \
        asm volatile("s_waitcnt lgkmcnt(0)" ::: "memory"); SBAR();   \
        o[d0] = __builtin_amdgcn_mfma_f32_32x32x16_bf16(pa0, (bf16x8){l0[0], l0[1], l0[2], l0[3], h0[0], h0[1], h0[2], h0[3]}, o[d0], 0, 0, 0);   \
        o[d0] = __builtin_amdgcn_mfma_f32_32x32x16_bf16(pa1, (bf16x8){l1[0], l1[1], l1[2], l1[3], h1[0], h1[1], h1[2], h1[3]}, o[d0], 0, 0, 0);   \
        o[d0] = __builtin_amdgcn_mfma_f32_32x32x16_bf16(pa2, (bf16x8){l2[0], l2[1], l2[2], l2[3], h2[0], h2[1], h2[2], h2[3]}, o[d0], 0, 0, 0);   \
        o[d0] = __builtin_amdgcn_mfma_f32_32x32x16_bf16(pa3, (bf16x8){l3[0], l3[1], l3[2], l3[3], h3[0], h3[1], h3[2], h3[3]}, o[d0], 0, 0, 0); } while (0)
    PV_D0(0); PV_D0(1); PV_D0(2); PV_D0(3);
#undef PV_D0
#undef TRRD
}
typedef float f32x2 __attribute__((ext_vector_type(2)));
struct BlockRef { const bf16* Q; const bf16* K; const bf16* V; bf16* O; const f32x2* CB; int P0; };
struct Seam { bf16x8 qr[8]; bf16x8 st_v0, st_v1, st_k0, st_k1; };
template <int LDQ, int LDO> struct Body {
#define ROW(p, k0, rr) ((p) + (unsigned)(((k0) + (rr)) * LDQ + sc))
#define VMW() asm volatile("s_waitcnt vmcnt(0)" ::: "memory")
#define VMWN(n) asm volatile("s_waitcnt vmcnt(%0)" :: "i"(n) : "memory")
#define SLOAD_H(Kp, Vp, k0) do { S.st_v0 = load8(ROW(Vp, k0, sr)); S.st_v1 = load8(ROW(Vp, k0, 32 + sr));              \
                         S.st_k0 = load8(ROW(Kp, k0, sr)); S.st_k1 = load8(ROW(Kp, k0, 32 + sr)); } while (0)
#define SWRITE_HK(bf) do { *(bf16x8*)(K_lds + (bf) * SHM_K + kws) = S.st_k0; *(bf16x8*)(K_lds + (bf) * SHM_K + kws + 32 * 256) = S.st_k1; } while (0)
#define SWRITE_HV(bf) do { *(bf16x8*)(V_lds + (bf) * SHM_V + vst0) = S.st_v0; *(bf16x8*)(V_lds + (bf) * SHM_V + vst1) = S.st_v1; } while (0)
#define SWRITE_H(bf) do { SWRITE_HV(bf); SWRITE_HK(bf); } while (0)
    static __device__ __forceinline__ void prime(const BlockRef& cur, char* lds, Seam& S) {
        const int tid = threadIdx.x, wid = __builtin_amdgcn_readfirstlane(tid >> 6), lane = tid & 63, r32 = lane & 31, hi = lane >> 5;
        const int sr = tid >> 4, sc = (tid & 15) * 8, kws = KSWZ(sr, sc * 2); char* K_lds = lds + 2 * SHM_V;
        const int kb0 = 0;
        for (int d0 = 0; d0 < 8; ++d0) S.qr[d0] = load8(cur.Q + (unsigned)((wid * QBLK + r32) * LDQ + d0 * 16 + hi * 8));
        SLOAD_H(cur.K, cur.V, kb0); VMW(); SWRITE_HK(0);
        __syncthreads();
    }
    static __device__ __forceinline__ void block(const BlockRef& cur, const BlockRef& nxt, int skv, char* lds, Seam& S) {
        const int tid = threadIdx.x, wid = __builtin_amdgcn_readfirstlane(tid >> 6), lane = tid & 63, r32 = lane & 31, hi = lane >> 5;
        const int W = skv;
        const int j_lo = 0;
        int j_hi = (cur.P0 + QB - 1) / KVBLK + 1; if (j_hi > skv / KVBLK) j_hi = skv / KVBLK;
        const int NT = j_hi - j_lo;
        const int kbn = 0;
        const int qlo = cur.P0 + wid * QBLK, qm = qlo + r32 - 4 * hi;
        char* V_lds = lds; char* K_lds = lds + 2 * SHM_V;
        float* ws = (float*)(lds + 2 * SHM_V + 2 * SHM_K) + wid * 64; float* li_l = ws, * al_l = ws + 32;
        float m_reg = -1e30f, l_reg = 0; f32x16 o[4] = {};
        const int sr = tid >> 4, sc = (tid & 15) * 8, vst0 = v_st(sr, sc), vst1 = v_st(32 + sr, sc), kws = KSWZ(sr, sc * 2);
        const int vb0 = (int)(uintptr_t)V_lds + v_rd_base(lane);
        const bf16* Kh = cur.K; const bf16* Vh = cur.V;
        const char* cbb = (const char*)cur.CB; const unsigned cbo = (unsigned)r32 * 8u;
        f32x2 bw = *(const f32x2*)(cbb + cbo);
#define BLOAD(t) do { bw = *(const f32x2*)(cbb + (cbo + (unsigned)((t) * 256))); } while (0)
#define RESC(a) do { if (__any((a) < 1.f)) { if (hi == 0) al_l[r32] = (a); asm volatile("s_waitcnt lgkmcnt(0)" ::: "memory");              \
                     for (int d_ = 0; d_ < 4; ++d_) for (int r = 0; r < 16; ++r) o[d_][r] *= al_l[crow(r, hi)]; } } while (0)
#define KBASE(t) ((j_lo + (t)) * KVBLK)
#define MASKT(P0_, P1_, t) do { const int kb_ = KBASE(t); if (kb_ + KVBLK - 1 > qlo || kb_ <= qlo + QBLK - 1 - W) mask_tile(P0_, P1_, qm - kb_, (unsigned)W); } while (0)
        constexpr int NQL = 8;
#define SEAM_K0() do { VMWN(NQL); SWRITE_HK(0); SBAR(); } while (0)
        f32x16 pA0, pA1, pB0, pB1; float mnA, mnB, alA, alB; bf16x8 pa0, pa1, pa2, pa3;
        SWRITE_HV(0); SBAR();
        if (NT > 1) { SLOAD_H(Kh, Vh, KBASE(1)); }
        SBAR(); qkt<0>(pA0, pA1, K_lds, r32, hi, S.qr, bw.x, bw.y); if (NT > 1) BLOAD(1);
        MASKT(pA0, pA1, 0); partialSM(pA0, pA1, m_reg, mnA, alA);
        if (NT > 1) { VMW(); SWRITE_H(1); }
        __syncthreads();
#define HALF_STEP(PX0, PX1, mnX, alX, PY0, PY1, alY, t, KB, VB, SB) do {                                                      \
        SBAR(); qkt<KB>(PX0, PX1, K_lds, r32, hi, S.qr, bw.x, bw.y); if ((t) + 1 < NT) BLOAD((t) + 1);                   \
        finishSM(PY0, PY1, alY, l_reg, pa0, pa1, pa2, pa3); SBAR();                                                           \
        if ((t) + 1 < NT) { SLOAD_H(Kh, Vh, KBASE((t) + 1)); SBAR(); }                                                       \
        pv_tile<VB>(o, vb0, pa0, pa1, pa2, pa3); MASKT(PX0, PX1, (t)); partialSM(PX0, PX1, m_reg, mnX, alX);                    \
        __syncthreads();                                                                                                      \
        if ((t) + 1 < NT) { VMW(); SWRITE_H(SB); }                                                                            \
        RESC(alX); __syncthreads(); } while (0)
        for (int t = 1; t + 1 < NT; t += 2) {
            HALF_STEP(pB0, pB1, mnB, alB, pA0, pA1, alA, t, 1, 0, 0);
            HALF_STEP(pA0, pA1, mnA, alA, pB0, pB1, alB, t + 1, 0, 1, 1);
        }
        const bool even = (NT & 1) == 0;
        if (even) { SBAR(); qkt<1>(pB0, pB1, K_lds, r32, hi, S.qr, bw.x, bw.y); SBAR(); }
        SLOAD_H(nxt.K, nxt.V, kbn); SBAR();
#pragma unroll
        for (int d0 = 0; d0 < 8; ++d0) S.qr[d0] = load8(nxt.Q + (unsigned)((wid * QBLK + r32) * LDQ + d0 * 16 + hi * 8));
        SBAR();
        finishSM(pA0, pA1, alA, l_reg, pa0, pa1, pa2, pa3); SBAR();
        pv_tile<0>(o, vb0, pa0, pa1, pa2, pa3);
        if (even) { MASKT(pB0, pB1, NT - 1); partialSM(pB0, pB1, m_reg, mnB, alB); __syncthreads(); RESC(alB);
            finishSM(pB0, pB1, alB, l_reg, pa0, pa1, pa2, pa3); SBAR(); pv_tile<1>(o, vb0, pa0, pa1, pa2, pa3); }
        SBAR(); SEAM_K0();
        if (hi == 0) li_l[r32] = l_reg; asm volatile("s_waitcnt lgkmcnt(0)" ::: "memory");
        float rli[16];
#pragma unroll
        for (int r = 0; r < 16; ++r) rli[r] = __builtin_amdgcn_rcpf(li_l[crow(r, hi)]);
        bf16* Ow = cur.O + (unsigned)((wid * QBLK) * LDO);
#pragma unroll
        for (int r = 0; r < 16; ++r) { const int orow = crow(r, hi);
#pragma unroll
            for (int d0 = 0; d0 < 4; ++d0) { const float v = o[d0][r] * rli[r];
                const float vn = __shfl_xor(v, 1);
                if ((r32 & 1) == 0) *(unsigned*)(Ow + (unsigned)(orow * LDO + d0 * 32 + r32)) = cvtpk(v, vn); } }
        __syncthreads();
#undef RESC
#undef KBASE
#undef MASKT
#undef SEAM_K0
#undef HALF_STEP
#undef BLOAD
    }
#undef ROW
#undef VMW
#undef VMWN
#undef SLOAD_H
#undef SWRITE_HK
#undef SWRITE_HV
#undef SWRITE_H
};
#undef KSWZ
#undef SBAR
}

constexpr int NWAVES = 8;
constexpr int DM = 4096, BATCH = 4, SEQ = 4096, M = BATCH * SEQ;
constexpr int NH = 16, HD = 128, HW = NH * HD;
constexpr int DFF = 11008, N_IN = 22576, CONVW = 3 * HW;
constexpr int LDP = 22528;
constexpr int PC_QA = 0, PC_KA = 2048, PC_VA = 4096, PC_ZA = 6144, PC_QB = 8192, PC_KB = 10240, PC_VB = 12288, PC_GA = 14336, PC_GB = 18432;
constexpr int SC_BETA = 8192, SC_ALPHA = 8208, SC_QB = 8224, SC_F = 14368, SC_GA = 14384;
constexpr int NSM = 48;
constexpr float EPS = 1e-6f;

constexpr size_t MiB = 1u << 20;
constexpr size_t WS_CTL = 0, CTL_ZERO_BYTES = 1 * MiB;
constexpr size_t WS_WIN = 1 * MiB;
constexpr size_t WS_WSM = 177 * MiB;
constexpr size_t WS_WA = 178 * MiB;
constexpr size_t WS_WB = 194 * MiB;
constexpr size_t WS_WO = 210 * MiB;
constexpr size_t WS_WGU = 242 * MiB;
constexpr size_t WS_WD = 414 * MiB;
constexpr size_t WS_XN = 500 * MiB;
constexpr size_t WS_OA = WS_XN, WS_OB = WS_XN + 64 * MiB;
constexpr size_t WS_SMALL = 628 * MiB;
constexpr size_t WS_CB = 631 * MiB;
constexpr size_t WS_P = 634 * MiB;
constexpr size_t WS_HN = WS_P, WS_ACT = WS_P + 128 * MiB;
constexpr size_t WS_MG = WS_WIN;
constexpr size_t WS_END = 1338 * MiB;
constexpr size_t WS_UF = WS_WIN;
constexpr size_t WS_EG = 512 * 1024;
constexpr int CW_BAR = 4096;
constexpr int CW_QUEUE = 8192;

constexpr int RING_OFF = 0, RING_BYTES = 155648;
constexpr int LDSCTL_OFF = RING_BYTES, MISC_OFF = LDSCTL_OFF + 320;
constexpr int LDS_BYTES = 157696;

#define GAS __attribute__((address_space(1)))
#define LAS __attribute__((address_space(3)))
typedef unsigned short bf16;
typedef unsigned v4u __attribute__((ext_vector_type(4)));
typedef unsigned v2u __attribute__((ext_vector_type(2)));
typedef float f32x4 __attribute__((ext_vector_type(4)));
typedef short bf16x8 __attribute__((ext_vector_type(8)));
#define LDS_WAIT() asm volatile("s_waitcnt lgkmcnt(0)" ::: "memory")
#define VM_WAIT() asm volatile("s_waitcnt vmcnt(0)" ::: "memory")
typedef float f32x2c __attribute__((ext_vector_type(2)));
typedef __bf16 bf16x2c __attribute__((ext_vector_type(2)));
__device__ __forceinline__ unsigned pk2(float lo, float hi) { const f32x2c v = {lo, hi}; return __builtin_bit_cast(unsigned, __builtin_convertvector(v, bf16x2c)); }
__device__ __forceinline__ unsigned f2bf(float f) { return pk2(f, f) & 0xffffu; }
__device__ __forceinline__ float bflo(unsigned w) { return __uint_as_float(w << 16); }
__device__ __forceinline__ float bfhi(unsigned w) { return __uint_as_float(w & 0xffff0000u); }
__device__ __forceinline__ float wave_sum(float v) {
#pragma unroll
    for (int o = 1; o < 64; o <<= 1) v += __shfl_xor(v, o);
    return v;
}
template <int CTRL> __device__ __forceinline__ float dppmov(float v) { return __builtin_bit_cast(float, __builtin_amdgcn_update_dpp(0, __builtin_bit_cast(int, v), CTRL, 0xF, 0xF, true)); }
__device__ __forceinline__ float sum8(float v) { v += dppmov<0xB1>(v); v += dppmov<0x4E>(v); v += dppmov<0x141>(v); return v; }
__device__ __forceinline__ float sum16(float v) { v = sum8(v); v += dppmov<0x140>(v); return v; }
__device__ __forceinline__ float silu_f(float x) { return x / (1.0f + __expf(-x)); }
__device__ __forceinline__ float silu_fast(float x) { return x * __builtin_amdgcn_rcpf(1.0f + __builtin_amdgcn_exp2f(-1.4426950408889634f * x)); }
__device__ __forceinline__ float sigm_f(float x) { return 1.0f / (1.0f + __expf(-x)); }
__device__ __forceinline__ float softplus_f(float x) { return fmaxf(x, 0.f) + log1pf(__expf(-fabsf(x))); }

#define XB_TMO      128
#define XB_XCNT(j)  (256  + 64 * (j))
#define XB_XSUB(j)  (1280 + 64 * (j))
#define XB_XGEN(j)  (2304 + 64 * (j))
#define XB_TOP      3328
#define XB_TOPGEN   3392
#define XCD_BAR_WORDS 3456
#define XB_SPIN_CAP (1u << 18)
__device__ __forceinline__ unsigned xb_ld(unsigned* p)              { return __hip_atomic_load(p, __ATOMIC_RELAXED, __HIP_MEMORY_SCOPE_AGENT); }
__device__ __forceinline__ unsigned xb_add(unsigned* p, unsigned v) { return __hip_atomic_fetch_add(p, v, __ATOMIC_RELAXED, __HIP_MEMORY_SCOPE_AGENT); }
__device__ __forceinline__ unsigned xb_xcc_id() { return (unsigned)__builtin_amdgcn_s_getreg((3 << 11) | 20) & 0xFu; }
#define XB_SPIN(cond, bar) do { unsigned _sp = 0; while (cond) { __builtin_amdgcn_s_sleep(1); \
    if ((++_sp & 255u) == 0u) { if (xb_ld(&(bar)[XB_TMO])) break; if (_sp > XB_SPIN_CAP) { atomicAdd(&(bar)[XB_TMO], 1u); break; } } } } while (0)
struct XcdBarrier { unsigned* bar; unsigned x; volatile LAS unsigned* st; };
__device__ __forceinline__ XcdBarrier xcd_barrier_post(unsigned* bar, volatile LAS unsigned* st) {
    XcdBarrier b; b.bar = bar; b.x = xb_xcc_id(); b.st = st;
    if (threadIdx.x == 0) (void)xb_add(&bar[XB_XCNT(b.x)], 1u);
    return b;
}
__device__ __forceinline__ void xcd_barrier_complete(unsigned* bar, unsigned x, unsigned& nloc, unsigned& nx) {
    const unsigned G = gridDim.x * gridDim.y * gridDim.z;
    unsigned sum, cnt, mine, sp = 0u;
    for (;;) {
        sum = 0u; cnt = 0u; mine = 0u;
#pragma unroll
        for (unsigned j = 0; j < 16; ++j) { const unsigned c = xb_ld(&bar[XB_XCNT(j)]); sum += c; cnt += (c > 0u) ? 1u : 0u; mine = (j == x) ? c : mine; }
        if (sum == G) break;
        __builtin_amdgcn_s_sleep(1);
        if ((++sp & 255u) == 0u) { if (xb_ld(&bar[XB_TMO])) break; if (sp > XB_SPIN_CAP) { atomicAdd(&bar[XB_TMO], 1u); break; } }
    }
    nloc = mine > 0u ? mine : 1u; nx = cnt > 0u ? cnt : 1u;
}
__device__ __forceinline__ void xcd_barrier(const XcdBarrier& b) {
    asm volatile("s_waitcnt vmcnt(0)" ::: "memory");
    __syncthreads();
    if (threadIdx.x == 0) {
        unsigned* bar = b.bar;
        __builtin_amdgcn_s_waitcnt(0);
        unsigned nloc = b.st[0], nx = b.st[1];
        if (nloc == 0u) { xcd_barrier_complete(bar, b.x, nloc, nx); b.st[0] = nloc; b.st[1] = nx; }
        const unsigned old = xb_add(&bar[XB_XSUB(b.x)], 1u);
        const unsigned gen = old / nloc;
        if (old + 1u == (gen + 1u) * nloc) {
            __builtin_amdgcn_fence(__ATOMIC_RELEASE, "agent");
            asm volatile("s_waitcnt vmcnt(0)" ::: "memory");
            const unsigned og = xb_add(&bar[XB_TOP], 1u);
            const unsigned tg = og / nx;
            if (og + 1u == (tg + 1u) * nx) xb_add(&bar[XB_TOPGEN], 1u);
            else XB_SPIN(xb_ld(&bar[XB_TOPGEN]) == tg, bar);
            __builtin_amdgcn_fence(__ATOMIC_ACQUIRE, "agent");
            xb_add(&bar[XB_XGEN(b.x)], 1u);
            asm volatile("s_waitcnt vmcnt(0)" ::: "memory");
        } else {
            XB_SPIN(xb_ld(&bar[XB_XGEN(b.x)]) == gen, bar);
            __builtin_amdgcn_fence(__ATOMIC_ACQUIRE, "agent");
            asm volatile("s_waitcnt vmcnt(0)" ::: "memory");
        }
    }
    __syncthreads();
}

__device__ __forceinline__ void transpose_items(const float* W, int K, int ldw, int src0, int ncols, int blk, int mul, int add, bf16* WT, LAS float* scr, int gw, int NGW, int lane) {
    const int nblk = ncols / 32, nitems = (K / 64) * nblk;
    for (int it = gw; it < nitems; it += NGW) {
        const int kb = it / nblk, nb = it - kb * nblk, k0 = 64 * kb, nl = 32 * nb;
        const int drow = (nl / blk) * mul + (nl % blk) + add;
        const float* src = W + (size_t)k0 * ldw + src0 + nl + (lane & 31);
        float tv[32];
#pragma unroll
        for (int i = 0; i < 32; ++i) tv[i] = src[(size_t)(2 * i + (lane >> 5)) * ldw];
#pragma unroll
        for (int i = 0; i < 32; ++i) scr[(2 * i + (lane >> 5)) * 33 + (lane & 31)] = tv[i];
        LDS_WAIT(); asm volatile("" ::: "memory");
        const int c = lane & 7;
#pragma unroll
        for (int j = 0; j < 4; ++j) { const int n = (lane >> 3) + 8 * j; const LAS float* s = scr + (8 * c) * 33 + n;
            v4u o; o.x = pk2(s[0 * 33], s[1 * 33]); o.y = pk2(s[2 * 33], s[3 * 33]); o.z = pk2(s[4 * 33], s[5 * 33]); o.w = pk2(s[6 * 33], s[7 * 33]);
            *(v4u*)(WT + (size_t)(drow + n) * K + k0 + 8 * c) = o; }
        LDS_WAIT(); asm volatile("" ::: "memory");
    }
}
__device__ __forceinline__ void transpose_items_pipe(const float* W, int K, int ldw, int src0, int ncols, int blk, int mul, int add, bf16* WT, LAS float* scr, int gw, int NGW, int lane) {
    const int nblk = ncols / 32, nitems = (K / 64) * nblk;
    int it = gw; if (it >= nitems) return;
    float tv[32];
    { const int kb = it / nblk, nb = it - kb * nblk; const float* src = W + (size_t)(64 * kb) * ldw + src0 + 32 * nb + (lane & 31);
#pragma unroll
      for (int i = 0; i < 32; ++i) tv[i] = src[(size_t)(2 * i + (lane >> 5)) * ldw]; }
    for (;;) {
        const int kb = it / nblk, nb = it - kb * nblk, k0 = 64 * kb, nl = 32 * nb;
        const int drow = (nl / blk) * mul + (nl % blk) + add;
        const int nit = it + NGW; const bool more = nit < nitems;
        float nv[32];
        { const int ld = more ? nit : it;
          const int kb2 = ld / nblk, nb2 = ld - kb2 * nblk; const float* src = W + (size_t)(64 * kb2) * ldw + src0 + 32 * nb2 + (lane & 31);
#pragma unroll
          for (int i = 0; i < 32; ++i) nv[i] = src[(size_t)(2 * i + (lane >> 5)) * ldw]; }
        asm volatile("" ::: "memory");
#pragma unroll
        for (int i = 0; i < 32; ++i) scr[(2 * i + (lane >> 5)) * 33 + (lane & 31)] = tv[i];
        LDS_WAIT(); asm volatile("" ::: "memory");
        const int c = lane & 7;
#pragma unroll
        for (int j = 0; j < 4; ++j) { const int n = (lane >> 3) + 8 * j; const LAS float* s = scr + (8 * c) * 33 + n;
            v4u o; o.x = pk2(s[0 * 33], s[1 * 33]); o.y = pk2(s[2 * 33], s[3 * 33]); o.z = pk2(s[4 * 33], s[5 * 33]); o.w = pk2(s[6 * 33], s[7 * 33]);
            *(v4u*)(WT + (size_t)(drow + n) * K + k0 + 8 * c) = o; }
        LDS_WAIT(); asm volatile("" ::: "memory");
        if (!more) break;
#pragma unroll
        for (int i = 0; i < 32; ++i) tv[i] = nv[i];
        it = nit;
    }
}
__device__ __forceinline__ void rms_row_to_bf16(const float* __restrict__ xrow, const float* __restrict__ w, bf16* __restrict__ orow, int lane) {
    const f32x4* xr = (const f32x4*)xrow + lane; const f32x4* wr = (const f32x4*)w + lane;
    f32x4 v[16], g[16]; float s = 0.f;
#pragma unroll
    for (int j = 0; j < 16; ++j) { v[j] = xr[64 * j]; g[j] = wr[64 * j]; }
#pragma unroll
    for (int j = 0; j < 16; ++j) s += (v[j].x * v[j].x + v[j].y * v[j].y) + (v[j].z * v[j].z + v[j].w * v[j].w);
    const float rstd = 1.0f / sqrtf(wave_sum(s) * (1.0f / DM) + EPS);
    unsigned long long* o8 = (unsigned long long*)orow + lane;
#pragma unroll
    for (int j = 0; j < 16; ++j)
        o8[64 * j] = (unsigned long long)pk2(v[j].x * rstd * g[j].x, v[j].y * rstd * g[j].y) | ((unsigned long long)pk2(v[j].z * rstd * g[j].z, v[j].w * rstd * g[j].w) << 32);
}
__device__ __forceinline__ void rms_row_bf16_to_bf16(const bf16* __restrict__ xrow, const float* __restrict__ w, bf16* __restrict__ orow, int lane) {
    const v4u* xr = (const v4u*)xrow + lane; const f32x4* wr = (const f32x4*)w + 2 * lane;
    v4u xv[8]; f32x4 g[16]; float s = 0.f;
#pragma unroll
    for (int j = 0; j < 8; ++j) { xv[j] = xr[64 * j]; g[2 * j] = wr[128 * j]; g[2 * j + 1] = wr[128 * j + 1]; }
    float v[64];
#pragma unroll
    for (int j = 0; j < 8; ++j) { v[8 * j] = bflo(xv[j].x); v[8 * j + 1] = bfhi(xv[j].x); v[8 * j + 2] = bflo(xv[j].y); v[8 * j + 3] = bfhi(xv[j].y);
        v[8 * j + 4] = bflo(xv[j].z); v[8 * j + 5] = bfhi(xv[j].z); v[8 * j + 6] = bflo(xv[j].w); v[8 * j + 7] = bfhi(xv[j].w); }
#pragma unroll
    for (int i = 0; i < 64; ++i) s += v[i] * v[i];
    const float rstd = 1.0f / sqrtf(wave_sum(s) * (1.0f / DM) + EPS);
    v4u* o = (v4u*)orow + lane;
#pragma unroll
    for (int j = 0; j < 8; ++j) { const f32x4 g0 = g[2 * j], g1 = g[2 * j + 1]; v4u ow;
        ow.x = pk2(v[8 * j] * rstd * g0.x, v[8 * j + 1] * rstd * g0.y); ow.y = pk2(v[8 * j + 2] * rstd * g0.z, v[8 * j + 3] * rstd * g0.w);
        ow.z = pk2(v[8 * j + 4] * rstd * g1.x, v[8 * j + 5] * rstd * g1.y); ow.w = pk2(v[8 * j + 6] * rstd * g1.z, v[8 * j + 7] * rstd * g1.w);
        o[64 * j] = ow; }
}
__device__ __forceinline__ void small_gemm(const bf16* XN, const bf16* WS, float* OUT, int gw, int NGW, int lane, int one_task = -1) {
    for (int task = (one_task >= 0 ? one_task : gw); task < M / 16; task += (one_task >= 0 ? M : NGW)) {
        const int m0 = task * 16;
        f32x4 acc[3] = {{0.f, 0.f, 0.f, 0.f}, {0.f, 0.f, 0.f, 0.f}, {0.f, 0.f, 0.f, 0.f}};
        const bf16* ap = XN + (size_t)(m0 + (lane & 15)) * DM + (lane >> 4) * 8;
        const bf16* bp = WS + (size_t)(lane & 15) * DM + (lane >> 4) * 8;
#pragma unroll 4
        for (int kt = 0; kt < DM / 32; ++kt) {
            const bf16x8 a = *(const bf16x8*)(ap + kt * 32);
#pragma unroll
            for (int nb = 0; nb < 3; ++nb) { const bf16x8 b = *(const bf16x8*)(bp + (size_t)nb * 16 * DM + kt * 32);
                acc[nb] = __builtin_amdgcn_mfma_f32_16x16x32_bf16(a, b, acc[nb], 0, 0, 0); }
        }
#pragma unroll
        for (int nb = 0; nb < 3; ++nb)
            *(f32x4*)(OUT + (size_t)(nb * 16 + (lane & 15)) * M + m0 + (lane >> 4) * 4) = acc[nb];
    }
}
__device__ __forceinline__ void fox_cumsum_wg(const float* SMALL, const float* b_f, unsigned* CB, int bh, LAS float* red) {
    const int tid = threadIdx.x, lane = tid & 63, wave = tid >> 6;
    const int b = bh / NH, h = bh % NH; const float bf = b_f[h];
    const f32x4* src = (const f32x4*)(SMALL + (size_t)(32 + h) * M + (size_t)b * SEQ + (size_t)tid * 8);
    const f32x4 v0 = src[0], v1 = src[1];
    float ls[8] = {v0.x, v0.y, v0.z, v0.w, v1.x, v1.y, v1.z, v1.w};
    float tot = 0.f;
#pragma unroll
    for (int i = 0; i < 8; ++i) { const float x = ls[i] + bf;
        tot += fminf(x, 0.f) - 0.6931471805599453f * __builtin_amdgcn_logf(1.0f + __builtin_amdgcn_exp2f(-1.4426950408889634f * fabsf(x))); ls[i] = tot; }
    float incl = tot;
#pragma unroll
    for (int o = 1; o < 64; o <<= 1) { const float t = __shfl_up(incl, o); if (lane >= o) incl += t; }
    if (lane == 63) red[wave] = incl;
    __syncthreads();
    float base = incl - tot;
#pragma unroll
    for (int w = 0; w < 7; ++w) base += (w < wave) ? red[w] : 0.f;
    float* dst = (float*)CB + ((size_t)bh * 64 + (tid >> 3)) * 32 * 2;
    const int p = (tid & 7) * 8;
#pragma unroll
    for (int i = 0; i < 8; ++i) dst[((p + i) & 31) * 2 + ((p + i) >> 5)] = -(base + ls[i]) * 11.313708498984761f;
}

constexpr int GREC = 57344;
constexpr int GR_W = 0, GR_Q = 16384, GR_K = 32768, GR_QK = 49152;
constexpr int RAWP = 784;
constexpr int G1_KB = 0, G1_QB = 17408, G1_RT = 34816, G1_AM = 71680, G1_SC = 89088, G1_RAW = 90112, G1_QKS = 143360;
#define GBAR() do { asm volatile("s_waitcnt lgkmcnt(0)" ::: "memory"); __builtin_amdgcn_s_barrier(); asm volatile("" ::: "memory"); } while (0)
__device__ __forceinline__ void g1_raw_offsets(unsigned (&roff)[7], int wave, int lane) {
#pragma unroll
    for (int i = 0; i < 7; ++i) { const int inst = i * 8 + wave; const int L = inst * 1024 + lane * 16; int row = L / RAWP; const int within = L - row * RAWP; if (row > 66) row = 66;
        int ten = within >> 8; const int chb = within & 255; if (ten > 2) ten = 2;
        roff[i] = (unsigned)(row * (LDP * 2) + ten * (HW * 2) + chb); }
}
__device__ __forceinline__ void g1_issue_raw(const char* base, const unsigned (&roff)[7], LAS unsigned char* raw, int wave) {
#pragma unroll
    for (int i = 0; i < 7; ++i) { const int inst = i * 8 + wave;
        if (inst < 52) __builtin_amdgcn_global_load_lds((const unsigned*)(base + roff[i]), (LAS unsigned*)(raw + inst * 1024), 16, 0, 0); }
}
__device__ __forceinline__ void gdn_prep_wg(const bf16* P, const float* SMALL, const float* conv_w, const float* a_log, const float* dt_bias,
                                            unsigned char* REC, bf16* UF, float* EG, LAS unsigned char* lds, int bh, int n0, int nch) {
    const int tid = threadIdx.x, lane = tid & 63, wave = __builtin_amdgcn_readfirstlane(tid >> 6);
    const int b = bh / NH, h = bh % NH;
    LAS unsigned char* kb = lds + G1_KB;
    LAS unsigned char* qb = lds + G1_QB;
    LAS unsigned char* RT = lds + G1_RT;
    LAS float* Amat = (LAS float*)(lds + G1_AM);
    LAS float* sc = (LAS float*)(lds + G1_SC);
    LAS unsigned char* raw = lds + G1_RAW;
    LAS unsigned char* QKs = lds + G1_QKS;
    LAS unsigned char* Tb = kb;
    LAS unsigned char* Ws = qb;
    const float Aexp = __expf(a_log[h]), dtb = dt_bias[h];
    float lg_b = 0.f, lg_a = 0.f;
    unsigned roff[7]; g1_raw_offsets(roff, wave, lane);
    const char* rbase = (const char*)P + (((size_t)b * SEQ + (size_t)n0 * 64) * LDP + h * HD) * 2 - (size_t)3 * LDP * 2;
    g1_issue_raw(rbase, roff, raw, wave);
    if (wave == 0) { const float* sm = SMALL + (size_t)b * SEQ + (size_t)n0 * 64 + lane; lg_b = sm[(size_t)h * M]; lg_a = sm[(size_t)(16 + h) * M]; }
    for (int k = 0; k < nch; ++k) {
        const int n = n0 + k, ci = bh * 64 + n;
        unsigned char* rec = REC + (size_t)ci * GREC;
        if (wave == 0) {
            const float be = sigm_f(lg_b);
            const float g = -Aexp * softplus_f(lg_a + dtb);
            float gc = g;
#pragma unroll
            for (int o = 1; o < 64; o <<= 1) { const float t = __shfl_up(gc, o); if (lane >= o) gc += t; }
            const float gl = __shfl(gc, 63);
            sc[lane] = gc; sc[64 + lane] = be; sc[128 + lane] = __expf(gc); sc[192 + lane] = __expf(gl - gc);
            if (lane == 63) EG[ci] = __expf(gl);
        }
        asm volatile("s_waitcnt vmcnt(0)" ::: "memory");
        GBAR();
        if (wave == 0 && k + 1 < nch) { const float* sm = SMALL + (size_t)b * SEQ + (size_t)(n + 1) * 64 + lane; lg_b = sm[(size_t)h * M]; lg_a = sm[(size_t)(16 + h) * M]; }
        {
            const int row = tid >> 3, cg = tid & 7, c0 = cg * 16;
            const int t = n * 64 + row;
            const float be = sc[64 + row], egc = sc[128 + row], egl = sc[192 + row];
#pragma unroll
            for (int ten = 0; ten < 3; ++ten) {
                const int pcol = ten * HW + h * HD + c0;
                float acc[16];
#pragma unroll
                for (int j = 0; j < 16; ++j) acc[j] = 0.f;
#pragma unroll
                for (int i = 0; i < 4; ++i) {
                    if (t - 3 + i >= 0) { const LAS unsigned char* src = raw + (row + i) * RAWP + ten * 256 + c0 * 2; const v4u x0 = *(const LAS v4u*)src, x1 = *(const LAS v4u*)(src + 16);
                        const float* w = conv_w + (size_t)i * CONVW + pcol;
                        const f32x4 w0 = *(const f32x4*)w, w1 = *(const f32x4*)(w + 4), w2 = *(const f32x4*)(w + 8), w3 = *(const f32x4*)(w + 12);
                        acc[0] += w0.x * bflo(x0.x); acc[1] += w0.y * bfhi(x0.x); acc[2] += w0.z * bflo(x0.y); acc[3] += w0.w * bfhi(x0.y);
                        acc[4] += w1.x * bflo(x0.z); acc[5] += w1.y * bfhi(x0.z); acc[6] += w1.z * bflo(x0.w); acc[7] += w1.w * bfhi(x0.w);
                        acc[8] += w2.x * bflo(x1.x); acc[9] += w2.y * bfhi(x1.x); acc[10] += w2.z * bflo(x1.y); acc[11] += w2.w * bfhi(x1.y);
                        acc[12] += w3.x * bflo(x1.z); acc[13] += w3.y * bfhi(x1.z); acc[14] += w3.z * bflo(x1.w); acc[15] += w3.w * bfhi(x1.w); } }
                float ss = 0.f;
#pragma unroll
                for (int j = 0; j < 16; ++j) { acc[j] = silu_fast(acc[j]); ss += acc[j] * acc[j]; }
                if (ten < 2) { ss = sum8(ss); const float s_ = (1.0f / sqrtf(ss + EPS)) * (ten == 0 ? 0.08838834764831845f : 1.0f);
#pragma unroll
                    for (int j = 0; j < 16; ++j) acc[j] *= s_; }
                if (ten == 0) {
                    v4u o0, o1; o0.x = pk2(acc[0], acc[1]); o0.y = pk2(acc[2], acc[3]); o0.z = pk2(acc[4], acc[5]); o0.w = pk2(acc[6], acc[7]);
                    o1.x = pk2(acc[8], acc[9]); o1.y = pk2(acc[10], acc[11]); o1.z = pk2(acc[12], acc[13]); o1.w = pk2(acc[14], acc[15]);
                    *(LAS v4u*)(qb + row * 272 + c0 * 2) = o0; *(LAS v4u*)(qb + row * 272 + c0 * 2 + 16) = o1;
                    unsigned char* dst = rec + GR_Q + ((row >> 4) * 4 + (c0 >> 5)) * 1024 + ((c0 >> 4) & 1) * 8;
#pragma unroll
                    for (int i = 0; i < 4; ++i) { v2u w; w.x = pk2(acc[4 * i] * egc, acc[4 * i + 1] * egc); w.y = pk2(acc[4 * i + 2] * egc, acc[4 * i + 3] * egc);
                        *(v2u*)(dst + ((row & 15) + 16 * i) * 16) = w; }
                } else if (ten == 1) {
                    v4u o0, o1; o0.x = pk2(acc[0], acc[1]); o0.y = pk2(acc[2], acc[3]); o0.z = pk2(acc[4], acc[5]); o0.w = pk2(acc[6], acc[7]);
                    o1.x = pk2(acc[8], acc[9]); o1.y = pk2(acc[10], acc[11]); o1.z = pk2(acc[12], acc[13]); o1.w = pk2(acc[14], acc[15]);
                    *(LAS v4u*)(kb + row * 272 + c0 * 2) = o0; *(LAS v4u*)(kb + row * 272 + c0 * 2 + 16) = o1;
                    const float bg = be * egc; const int off = row & 31, kq = (off & 15) >> 2, kj = (off & 3) + 4 * (off >> 4);
                    unsigned char* dst = rec + GR_K + ((c0 >> 4) * 2 + (row >> 5)) * 1024 + (16 * kq) * 16 + kj * 2;
#pragma unroll
                    for (int e = 0; e < 16; ++e) { *(LAS bf16*)(RT + (128 + c0 + e) * 144 + row * 2) = (bf16)f2bf(acc[e] * bg);
                        *(bf16*)(dst + e * 16) = (bf16)f2bf(acc[e] * egl); }
                } else {
#pragma unroll
                    for (int e = 0; e < 16; ++e) *(LAS bf16*)(RT + (c0 + e) * 144 + row * 2) = (bf16)f2bf(acc[e] * be);
                }
            }
        }
        GBAR();
        if (k + 1 < nch) g1_issue_raw(rbase + (size_t)(k + 1) * 64 * LDP * 2, roff, raw, wave);
        {
            const int fr = lane & 15, fq = lane >> 4;
#pragma unroll
            for (int i = 0; i < 4; ++i) {
                const int id = wave * 4 + i, mat = id >> 4, ct = (id >> 2) & 3, jt = id & 3;
                f32x4 acc = {0.f, 0.f, 0.f, 0.f};
                if (jt <= ct) {
                    const LAS unsigned char* ap = (mat ? qb : kb) + (16 * ct + fr) * 272 + fq * 16;
                    const LAS unsigned char* bp = kb + (16 * jt + fr) * 272 + fq * 16;
#pragma unroll
                    for (int ks = 0; ks < 4; ++ks) acc = __builtin_amdgcn_mfma_f32_16x16x32_bf16(*(const LAS bf16x8*)(ap + ks * 64), *(const LAS bf16x8*)(bp + ks * 64), acc, 0, 0, 0);
                }
                const int j = 16 * jt + fr; const float gj = sc[j];
#pragma unroll
                for (int r = 0; r < 4; ++r) { const int ii = 16 * ct + 4 * fq + r; const float dec = __expf(fminf(sc[ii] - gj, 0.f));
                    if (mat == 0) Amat[ii * 68 + (j & 7) * 8 + (j >> 3)] = (j < ii) ? acc[r] * sc[64 + ii] * dec : 0.f;
                    else { const float v = (j <= ii) ? acc[r] * dec : 0.f;
                        *(LAS bf16*)(QKs + (ct * 2 + (jt >> 1)) * 1024 + ((4 * fq + r) + 16 * (fr >> 2)) * 16 + ((fr & 3) + 4 * (jt & 1)) * 2) = (bf16)f2bf(v); } }
            }
        }
        GBAR();
        *(v4u*)(rec + GR_QK + tid * 16) = *(const LAS v4u*)(QKs + tid * 16);
        {
            const int cl = lane >> 3, part = lane & 7, c = wave * 8 + cl;
            float tc[8], pm[8];
#pragma unroll
            for (int m = 0; m < 8; ++m) { tc[m] = (m == (c >> 3) && part == (c & 7)) ? 1.f : 0.f; pm[m] = (part == m) ? 1.f : 0.f; }
            f32x4 na0 = *(const LAS f32x4*)(Amat + 1 * 68 + part * 8), na1 = (f32x4){0.f, 0.f, 0.f, 0.f};
#pragma unroll
            for (int i = 1; i < 64; ++i) {
                const f32x4 a0 = na0, a1 = na1;
                if (i + 1 < 64) { const LAS f32x4* ar = (const LAS f32x4*)(Amat + (i + 1) * 68 + part * 8); na0 = ar[0]; if (i + 1 > 32) na1 = ar[1]; }
                asm volatile("" ::: "memory");
                float s0 = a0.x * tc[0], s1 = a0.y * tc[1];
                if (i > 16) { s0 += a0.z * tc[2]; s1 += a0.w * tc[3]; } else if (i > 8) { s0 += a0.z * tc[2]; }
                if (i > 32) { s0 += a1.x * tc[4]; if (i > 40) s1 += a1.y * tc[5]; if (i > 48) s0 += a1.z * tc[6]; if (i > 56) s1 += a1.w * tc[7]; }
                const float s = sum8(s0 + s1);
                tc[i >> 3] = fmaf(-s, pm[i & 7], tc[i >> 3]);
            }
#pragma unroll
            for (int m = 0; m < 8; ++m) *(LAS bf16*)(Tb + (part + 8 * m) * 144 + c * 2) = (bf16)f2bf(tc[m]);
        }
        GBAR();
        {
            const int fr = lane & 15, fq = lane >> 4;
#pragma unroll
            for (int nt = 0; nt < 2; ++nt) {
                const int col = 32 * wave + 16 * nt + fr;
                f32x4 acc[4];
                const LAS unsigned char* bp = RT + col * 144 + fq * 16;
                const bf16x8 b0 = *(const LAS bf16x8*)bp, b1 = *(const LAS bf16x8*)(bp + 64);
#pragma unroll
                for (int ct = 0; ct < 4; ++ct) { const LAS unsigned char* ap = Tb + (16 * ct + fr) * 144 + fq * 16;
                    acc[ct] = (f32x4){0.f, 0.f, 0.f, 0.f};
                    acc[ct] = __builtin_amdgcn_mfma_f32_16x16x32_bf16(*(const LAS bf16x8*)ap, b0, acc[ct], 0, 0, 0);
                    acc[ct] = __builtin_amdgcn_mfma_f32_16x16x32_bf16(*(const LAS bf16x8*)(ap + 64), b1, acc[ct], 0, 0, 0); }
                if (wave < 4) {
                    v4u o0, o1; o0.x = pk2(acc[0][0], acc[0][1]); o0.y = pk2(acc[0][2], acc[0][3]); o0.z = pk2(acc[1][0], acc[1][1]); o0.w = pk2(acc[1][2], acc[1][3]);
                    o1.x = pk2(acc[2][0], acc[2][1]); o1.y = pk2(acc[2][2], acc[2][3]); o1.z = pk2(acc[3][0], acc[3][1]); o1.w = pk2(acc[3][2], acc[3][3]);
                    bf16* dst = UF + (((size_t)ci * 8 + (2 * wave + nt)) * 64 + lane) * 16;
                    *(v4u*)dst = o0; *(v4u*)(dst + 8) = o1;
                } else {
#pragma unroll
                    for (int ct = 0; ct < 4; ++ct)
#pragma unroll
                        for (int r = 0; r < 4; ++r)
                            *(LAS bf16*)(Ws + (ct * 4 + (wave - 4)) * 1024 + ((4 * fq + r) + 16 * (fr >> 2)) * 16 + ((fr & 3) + 4 * nt) * 2) = (bf16)f2bf(-acc[ct][r]);
                }
            }
        }
        GBAR();
        *(v4u*)(rec + GR_W + tid * 16) = *(const LAS v4u*)(Ws + tid * 16);
        *(v4u*)(rec + GR_W + 8192 + tid * 16) = *(const LAS v4u*)(Ws + 8192 + tid * 16);
    }
    asm volatile("s_waitcnt vmcnt(0) lgkmcnt(0)" ::: "memory");
    __syncthreads();
}
__device__ __forceinline__ bf16x8 pack_b(const f32x4 t0, const f32x4 t1) {
    v4u w; w.x = pk2(t0[0], t0[1]); w.y = pk2(t0[2], t0[3]); w.z = pk2(t1[0], t1[1]); w.w = pk2(t1[2], t1[3]);
    return *reinterpret_cast<bf16x8*>(&w);
}
constexpr int G2_OB = 2 * GREC, G2_OBP = 272;
__device__ __forceinline__ void gdn_scan8(const unsigned char* REC, const bf16* UF, const float* EG, bf16* OA, const bf16* P, const float* norm_w, LAS unsigned char* lds, int bh) {
    const int tid = threadIdx.x, lane = tid & 63, wave = __builtin_amdgcn_readfirstlane(tid >> 6);
    const int b = bh / NH, h = bh % NH, fr = lane & 15, fq = lane >> 4;
    const unsigned char* recb = REC + (size_t)bh * 64 * GREC;
#define GSTAGE(nn, bufi) do { _Pragma("unroll") for (int i_ = 0; i_ < 7; ++i_) { const int p_ = wave + 8 * i_; \
        __builtin_amdgcn_global_load_lds((const unsigned*)(recb + (size_t)(nn) * GREC + p_ * 1024 + lane * 16), (LAS unsigned*)(lds + (bufi) * GREC + p_ * 1024), 16, 0, 0); } } while (0)
    f32x4 S[8];
#pragma unroll
    for (int i = 0; i < 8; ++i) S[i] = (f32x4){0.f, 0.f, 0.f, 0.f};
    const bf16* ufp = UF + (((size_t)bh * 64 * 8 + wave) * 64 + lane) * 16;
    float w8[8];
#pragma unroll
    for (int j = 0; j < 8; ++j) w8[j] = norm_w[fr * 8 + j];
    const bf16* zp = P + ((size_t)b * SEQ + 8 * wave + fq) * LDP + PC_ZA + h * HD + fr * 8;
    bf16* op = OA + ((size_t)b * SEQ + 8 * wave + fq) * HW + h * HD + fr * 8;
    v4u u0 = *(const v4u*)ufp, u1 = *(const v4u*)(ufp + 8); float eg = EG[bh * 64];
    v4u z0 = {0u, 0u, 0u, 0u}, z1 = {0u, 0u, 0u, 0u};
    GSTAGE(0, 0);
    asm volatile("s_waitcnt vmcnt(0)" ::: "memory");
    __syncthreads();
#define G2_NORM_OUT(nn) do { const LAS unsigned char* ob_ = lds + G2_OB + ((nn) & 1) * (64 * G2_OBP) + (8 * wave + fq) * G2_OBP + fr * 16; \
        _Pragma("unroll") for (int j_ = 0; j_ < 2; ++j_) { const v4u x_ = *(const LAS v4u*)(ob_ + j_ * 4 * G2_OBP); const v4u z_ = j_ ? z1 : z0; \
            float v_[8] = {bflo(x_.x), bfhi(x_.x), bflo(x_.y), bfhi(x_.y), bflo(x_.z), bfhi(x_.z), bflo(x_.w), bfhi(x_.w)}; \
            const float zz_[8] = {bflo(z_.x), bfhi(z_.x), bflo(z_.y), bfhi(z_.y), bflo(z_.z), bfhi(z_.z), bflo(z_.w), bfhi(z_.w)}; \
            float ss_ = 0.f; _Pragma("unroll") for (int e_ = 0; e_ < 8; ++e_) ss_ += v_[e_] * v_[e_]; \
            ss_ = sum16(ss_); const float rs_ = 1.0f / sqrtf(ss_ * (1.0f / HD) + EPS); \
            _Pragma("unroll") for (int e_ = 0; e_ < 8; ++e_) v_[e_] = v_[e_] * rs_ * w8[e_] * silu_f(zz_[e_]); \
            v4u o_; o_.x = pk2(v_[0], v_[1]); o_.y = pk2(v_[2], v_[3]); o_.z = pk2(v_[4], v_[5]); o_.w = pk2(v_[6], v_[7]); \
            *(v4u*)(op + ((size_t)(nn) * 64 + 4 * j_) * HW) = o_; } } while (0)
    for (int n = 0; n < 64; ++n) {
        if (n > 0) G2_NORM_OUT(n - 1);
        f32x4 Vn[4], O[4]; const float egc = eg;
        Vn[0] = (f32x4){bflo(u0.x), bfhi(u0.x), bflo(u0.y), bfhi(u0.y)}; Vn[1] = (f32x4){bflo(u0.z), bfhi(u0.z), bflo(u0.w), bfhi(u0.w)};
        Vn[2] = (f32x4){bflo(u1.x), bfhi(u1.x), bflo(u1.y), bfhi(u1.y)}; Vn[3] = (f32x4){bflo(u1.z), bfhi(u1.z), bflo(u1.w), bfhi(u1.w)};
        { const bf16* zq = zp + (size_t)n * 64 * LDP; z0 = *(const v4u*)zq; z1 = *(const v4u*)(zq + (size_t)4 * LDP); }
        if (n + 1 < 64) { const bf16* up = ufp + (size_t)(n + 1) * (8 * 64 * 16); u0 = *(const v4u*)up; u1 = *(const v4u*)(up + 8); eg = EG[bh * 64 + n + 1]; }
        __builtin_amdgcn_sched_barrier(0);
        if (n + 1 < 64) GSTAGE(n + 1, (n + 1) & 1);
        __builtin_amdgcn_sched_barrier(0);
        bf16x8 Sb[4];
#pragma unroll
        for (int ks = 0; ks < 4; ++ks) Sb[ks] = pack_b(S[2 * ks], S[2 * ks + 1]);
        const LAS unsigned char* base = lds + (n & 1) * GREC + lane * 16;
#pragma unroll
        for (int ct = 0; ct < 4; ++ct) { O[ct] = (f32x4){0.f, 0.f, 0.f, 0.f};
#pragma unroll
            for (int ks = 0; ks < 4; ++ks) {
                Vn[ct] = __builtin_amdgcn_mfma_f32_16x16x32_bf16(*(const LAS bf16x8*)(base + GR_W + (ct * 4 + ks) * 1024), Sb[ks], Vn[ct], 0, 0, 0);
                O[ct] = __builtin_amdgcn_mfma_f32_16x16x32_bf16(*(const LAS bf16x8*)(base + GR_Q + (ct * 4 + ks) * 1024), Sb[ks], O[ct], 0, 0, 0); } }
        bf16x8 Vb[2];
        Vb[0] = pack_b(Vn[0], Vn[1]); Vb[1] = pack_b(Vn[2], Vn[3]);
#pragma unroll
        for (int ct = 0; ct < 4; ++ct)
#pragma unroll
            for (int ks = 0; ks < 2; ++ks) O[ct] = __builtin_amdgcn_mfma_f32_16x16x32_bf16(*(const LAS bf16x8*)(base + GR_QK + (ct * 2 + ks) * 1024), Vb[ks], O[ct], 0, 0, 0);
#pragma unroll
        for (int dt = 0; dt < 8; ++dt) { S[dt] = S[dt] * egc;
#pragma unroll
            for (int ks = 0; ks < 2; ++ks) S[dt] = __builtin_amdgcn_mfma_f32_16x16x32_bf16(*(const LAS bf16x8*)(base + GR_K + (dt * 2 + ks) * 1024), Vb[ks], S[dt], 0, 0, 0); }
        { LAS unsigned char* ow = lds + G2_OB + (n & 1) * (64 * G2_OBP) + (4 * fq) * G2_OBP + (16 * wave + fr) * 2;
#pragma unroll
          for (int ct = 0; ct < 4; ++ct)
#pragma unroll
              for (int r = 0; r < 4; ++r) *(LAS bf16*)(ow + (16 * ct + r) * G2_OBP) = (bf16)f2bf(O[ct][r]); }
        asm volatile("s_waitcnt vmcnt(0)" ::: "memory");
        __syncthreads();
    }
    G2_NORM_OUT(63);
#undef G2_NORM_OUT
#undef GSTAGE
    __syncthreads();
}
__device__ __forceinline__ int fox_jlo(const unsigned* CB, int bh, int qb, float skipT, float be, int lane) {
    const float b0 = __builtin_bit_cast(float, __builtin_amdgcn_readfirstlane(__builtin_bit_cast(int, ((const float*)CB)[((size_t)bh * 64 + 4 * qb) * 64])));
    const unsigned long long m = __ballot((lane < 4 * qb) && (b0 - be > skipT));
    return __builtin_amdgcn_readfirstlane((int)__popcll(m));
}
__device__ __forceinline__ fox::BlockRef fox_mkref(bf16* P, bf16* OB, unsigned* CB, int bh, int qb, int jlo) {
    const int b = bh / NH, h = bh % NH;
    fox::BlockRef r; const size_t row0 = (size_t)b * SEQ, rowk = row0 + (size_t)jlo * fox::KVBLK;
    r.Q = P + (row0 + (size_t)qb * fox::QB) * LDP + PC_QB + h * HD; r.K = P + rowk * LDP + PC_KB + h * HD; r.V = P + rowk * LDP + PC_VB + h * HD;
    r.O = OB + (row0 + (size_t)qb * fox::QB) * HW + h * HD; r.CB = (const fox::f32x2*)CB + ((size_t)bh * 64 + jlo) * 32; r.P0 = qb * fox::QB - jlo * fox::KVBLK; return r;
}
#ifndef MK_N_LAUNCHES
#define MK_N_LAUNCHES 1
#endif
constexpr int N_PHASES = 10;
#ifndef REP_PHASE
#define REP_PHASE -1
#endif
struct Args { const float* in[17]; float* out; unsigned char* ws; int ph_lo, ph_hi; };
__global__ void __launch_bounds__(NWAVES * 64, 2) mk_fwd(Args args) {
    extern __shared__ __attribute__((aligned(16))) unsigned char lds_raw[];
    LAS unsigned char* lds = (LAS unsigned char*)lds_raw;
    volatile LAS unsigned* MISC = (volatile LAS unsigned*)(lds + MISC_OFF);
    const int tid = threadIdx.x, lane = tid & 63, wave = __builtin_amdgcn_readfirstlane(tid >> 6);
    const int G = gridDim.x, bx = blockIdx.x;
    const int vcu = (G % 8 == 0) ? (bx % 8) * (G / 8) + bx / 8 : bx;
    const int gw = vcu * NWAVES + wave, NGW = G * NWAVES;
    unsigned char* ws = args.ws;
    const float* x = args.in[0]; const float* norm_mix_w = args.in[1]; const float* w_in = args.in[2]; const float* conv_w = args.in[3];
    const float* a_log = args.in[4]; const float* dt_bias = args.in[5]; const float* gdn_norm_w = args.in[6]; const float* fox_b_f = args.in[7];
    const float* fox_qn = args.in[8]; const float* fox_kn = args.in[9]; const float* w_ba = args.in[10]; const float* w_bb = args.in[11];
    const float* w_out = args.in[12]; const float* norm_ffn_w = args.in[13]; const float* w_g = args.in[14]; const float* w_u = args.in[15]; const float* w_d = args.in[16];
    float* out = args.out;
    bf16* WIN = (bf16*)(ws + WS_WIN); bf16* WSM = (bf16*)(ws + WS_WSM); bf16* WA = (bf16*)(ws + WS_WA); bf16* WB = (bf16*)(ws + WS_WB); bf16* WO = (bf16*)(ws + WS_WO);
    bf16* WGU = (bf16*)(ws + WS_WGU); bf16* WD = (bf16*)(ws + WS_WD); bf16* XN = (bf16*)(ws + WS_XN); bf16* OA = (bf16*)(ws + WS_OA); bf16* OB = (bf16*)(ws + WS_OB);
    float* SMALL = (float*)(ws + WS_SMALL); unsigned* CB = (unsigned*)(ws + WS_CB); bf16* P = (bf16*)(ws + WS_P); bf16* HN = (bf16*)(ws + WS_HN); bf16* ACT = (bf16*)(ws + WS_ACT);
    bf16* HB = (bf16*)(ws + WS_XN);
    bf16* MG = (bf16*)(ws + WS_MG); bf16* UF = (bf16*)(ws + WS_UF); float* EGp = (float*)(ws + WS_EG);
    unsigned* ctl = (unsigned*)(ws + WS_CTL);

    for (int u = tid; u < (LDS_BYTES - LDSCTL_OFF) / 4; u += NWAVES * 64) ((LAS unsigned*)(lds + LDSCTL_OFF))[u] = 0u;
    __syncthreads();
    XcdBarrier bar; bar.bar = ctl + CW_BAR; bar.x = 0; bar.st = nullptr;
    const int lo = args.ph_lo, hi = args.ph_hi;
    if (hi - lo > 1) bar = xcd_barrier_post(ctl + CW_BAR, MISC + 8);
#ifndef PHASE_MASK
#define PHASE_MASK 0xFFFF
#endif
#define IN(k) (((PHASE_MASK >> (k)) & 1) && lo <= (k) && (k) < hi)
#define SEAM(k) do { if (IN(k) && IN((k) + 1)) xcd_barrier(bar); } while (0)

    const bool wd_late = (G == 256) && IN(0) && IN(8);
    const bool fused01 = (hi - lo > 1) && IN(0) && IN(1) && G == 256;
    if (IN(0)) {
        LAS float* scr = (LAS float*)(lds + RING_OFF + wave * 16384);
        for (int idx = (vcu * NWAVES * 64 + tid); idx < NSM * DM; idx += G * NWAVES * 64) { const int r = idx / DM, k = idx - r * DM;
            const int col = r < 16 ? SC_BETA + r : r < 32 ? SC_ALPHA + (r - 16) : SC_F + (r - 32);
            WSM[idx] = (bf16)f2bf(w_in[(size_t)k * N_IN + col]); }
        if (fused01) {
            xcd_barrier(bar);
            for (int j = 0; j < 8; ++j) { const int m = vcu * 64 + wave * 8 + j; rms_row_to_bf16(x + (size_t)m * DM, norm_mix_w, XN + (size_t)m * DM, lane); }
            asm volatile("s_waitcnt vmcnt(0)" ::: "memory"); __syncthreads();
            if (wave < 4) small_gemm(XN, WSM, SMALL, 0, 1, lane, vcu * 4 + wave);
        } else {
            for (int m = gw; m < M; m += NGW) rms_row_to_bf16(x + (size_t)m * DM, norm_mix_w, XN + (size_t)m * DM, lane);
        }
        transpose_items(w_in, DM, N_IN, 0, 8192, 1 << 30, 0, 0, WIN, scr, gw, NGW, lane);
        transpose_items(w_in, DM, N_IN, SC_QB, 6144, 1 << 30, 0, PC_QB, WIN, scr, gw, NGW, lane);
        transpose_items(w_in, DM, N_IN, SC_GA, 8192, 1 << 30, 0, PC_GA, WIN, scr, gw, NGW, lane);
        transpose_items(w_ba, HW, DM, 0, DM, 1 << 30, 0, 0, WA, scr, gw, NGW, lane);
        transpose_items(w_bb, HW, DM, 0, DM, 1 << 30, 0, 0, WB, scr, gw, NGW, lane);
        transpose_items(w_out, DM, DM, 0, DM, 1 << 30, 0, 0, WO, scr, gw, NGW, lane);
        transpose_items(w_g, DM, DFF, 0, DFF, 128, 256, 0, WGU, scr, gw, NGW, lane);
        transpose_items(w_u, DM, DFF, 0, DFF, 128, 256, 128, WGU, scr, gw, NGW, lane);
        if (!wd_late) transpose_items(w_d, DFF, DM, 0, DM, 1 << 30, 0, 0, WD, scr, gw, NGW, lane);
    }
    SEAM(0);
    if (IN(1)) {
        if (!fused01) small_gemm(XN, WSM, SMALL, gw, NGW, lane);
        pg8::Gemm g{XN, WIN, M, LDP, DM}; pg8::StaticOrder S; S.init(M, LDP, G, bx);
        pg8::EpiStoreBf16 E{P, LDP, fox_qn, fox_kn, (LAS float*)(lds + RING_OFF + 131072), PC_QB / 256, PC_KB / 256, PC_VB / 256, EPS};
        pg8::gemm_phase<pg8::EpiStoreBf16, pg8::StaticOrder, true, true>(lds + RING_OFF, g, S, E);
    }
    SEAM(1);
    if (IN(2)) {
        if (bx < BATCH * NH) fox_cumsum_wg(SMALL, fox_b_f, CB, bx, (LAS float*)(lds + RING_OFF));
        for (int idx = bx; idx < 4 * BATCH * NH; idx += G) gdn_prep_wg(P, SMALL, conv_w, a_log, dt_bias, (unsigned char*)out, UF, EGp, lds + RING_OFF, (idx >> 2) & 63, (idx & 3) * 16, 16);
    }
    SEAM(2);
    if (IN(3)) {
        typedef fox::Body<LDP, HW> FB;
        char* albs = (char*)lds_raw + RING_OFF;
        if (bx < BATCH * NH) gdn_scan8((const unsigned char*)out, UF, EGp, OA, P, gdn_norm_w, lds + RING_OFF, bx);
        float skipT;
        { float mq = fmaxf(fabsf(fox_qn[lane]), fabsf(fox_qn[64 + lane])), mk = fmaxf(fabsf(fox_kn[lane]), fabsf(fox_kn[64 + lane]));
#pragma unroll
          for (int o = 1; o < 64; o <<= 1) { mq = fmaxf(mq, __shfl_xor(mq, o)); mk = fmaxf(mk, __shfl_xor(mk, o)); }
          const float Bq = 11.3137085f * 1.02f * mq * mk;
          skipT = __builtin_bit_cast(float, __builtin_amdgcn_readfirstlane(__builtin_bit_cast(int, 11.3137085f * (92.9f + 2.0f * Bq + 3.0f)))); }
        constexpr int NITEMS = BATCH * NH * (SEQ / fox::QB);
        unsigned* qhead = ctl + CW_QUEUE;
        constexpr unsigned NA = 192, NC = (unsigned)NITEMS - 2 * NA;
#define FOX_GETC() ({ unsigned r_ = xb_add(qhead + 128, 1u); if (r_ < NC) r_ += NA; else { r_ = xb_add(qhead + 64, 1u); r_ = r_ < NA ? (unsigned)NITEMS - 1u - r_ : (unsigned)NITEMS; } r_; })
#define FOX_GETA() ({ unsigned r_ = xb_add(qhead, 1u); if (r_ >= NA) r_ = FOX_GETC(); r_; })
#define FOX_GETB() ({ unsigned r_ = xb_add(qhead + 64, 1u); r_ = r_ < NA ? (unsigned)NITEMS - 1u - r_ : FOX_GETC(); r_; })
#define FOX_FETCH(slot) do { if (tid == 0) MISC[12 + (slot)] = FOX_GETC(); } while (0)
#define FOX_REF(it) fox_mkref(P, OB, CB, (int)((it) & 63u), 15 - (int)((it) >> 6), fox_jlo(CB, (int)((it) & 63u), 15 - (int)((it) >> 6), skipT, ((const float*)CB)[((size_t)((it) & 63u) * 64 + lane) * 64 + 63], lane))
        if (tid == 0) { if (bx < BATCH * NH) { MISC[12] = FOX_GETC(); MISC[13] = FOX_GETC(); } else { MISC[12] = FOX_GETA(); MISC[13] = FOX_GETB(); } }
        __syncthreads();
        unsigned it0 = (unsigned)__builtin_amdgcn_readfirstlane((int)MISC[12]), it1 = (unsigned)__builtin_amdgcn_readfirstlane((int)MISC[13]);
        __syncthreads();
        if (it0 < (unsigned)NITEMS) {
            fox::BlockRef cur = FOX_REF(it0);
            fox::Seam Sm;
            FB::prime(cur, albs, Sm);
            for (;;) {
                const bool more = it1 < (unsigned)NITEMS;
                const fox::BlockRef nxt = more ? FOX_REF(it1) : cur;
                FB::block(cur, nxt, SEQ, albs, Sm);
                if (!more) break;
                FOX_FETCH(0);
                __syncthreads();
                cur = nxt; it1 = (unsigned)__builtin_amdgcn_readfirstlane((int)MISC[12]);
                __syncthreads();
            }
        }
#undef FOX_FETCH
#undef FOX_GETA
#undef FOX_GETB
#undef FOX_GETC
#undef FOX_REF
    }
    SEAM(3);
    if (IN(4)) {
        pg8::Gemm g{OA, WA, M, DM, HW}; pg8::StaticOrder S; S.init(M, DM, G, bx);
        pg8::EpiBranch<true> E{MG, DM, P + PC_GA, LDP};
        pg8::gemm_phase<pg8::EpiBranch<true>, pg8::StaticOrder, true, true>(lds + RING_OFF, g, S, E);
    }
    if (IN(4) && IN(5)) { asm volatile("s_waitcnt vmcnt(0)" ::: "memory"); __syncthreads(); }
    if (IN(5)) {
        pg8::Gemm g{OB, WB, M, DM, HW}; pg8::StaticOrder S; S.init(M, DM, G, bx);
        pg8::EpiBranch<false> E{MG, DM, P + PC_GB, LDP};
        pg8::gemm_phase<pg8::EpiBranch<false>, pg8::StaticOrder, true, true>(lds + RING_OFF, g, S, E);
    }
    SEAM(5);
    if (IN(6)) {
        pg8::Gemm g{MG, WO, M, DM, DM}; pg8::StaticOrder S; S.init(M, DM, G, bx);
        pg8::EpiResidToBf16 E{x, HB, DM};
        pg8::gemm_phase<pg8::EpiResidToBf16, pg8::StaticOrder, true, true>(lds + RING_OFF, g, S, E);
    }
    SEAM(6);
    if (IN(7)) {
        for (int m = gw; m < M; m += NGW) rms_row_bf16_to_bf16(HB + (size_t)m * DM, norm_ffn_w, HN + (size_t)m * DM, lane);
    }
    SEAM(7);
    if (IN(8)) {
        pg8::Gemm g{HN, WGU, M, 2 * DFF, DM}; pg8::StaticOrder S; S.init(M, 2 * DFF, G, bx);
        pg8::EpiSwiglu E{ACT, DFF};
        pg8::gemm_phase<pg8::EpiSwiglu, pg8::StaticOrder, true, true>(lds + RING_OFF, g, S, E);
        if (wd_late && bx >= (M / 256) * (2 * DFF / 256) % 256) {
            LAS float* scr = (LAS float*)(lds + RING_OFF + wave * 16384);
            transpose_items_pipe(w_d, DFF, DM, 0, DM, 1 << 30, 0, 0, WD, scr, (bx - 128) * NWAVES + wave, 128 * NWAVES, lane);
        }
    }
    SEAM(8);
    if (IN(9)) {
        pg8::Gemm g{ACT, WD, M, DM, DFF}; pg8::StaticOrder S; S.init(M, DM, G, bx);
        pg8::EpiResidFromBf16 E{HB, out, DM};
        pg8::gemm_phase<pg8::EpiResidFromBf16, pg8::StaticOrder, true, true>(lds + RING_OFF, g, S, E);
    }
#undef IN
#undef SEAM
}

extern "C" void kernel_launch(void* const* d_in, const int* in_sizes, int n_in, void* d_out, int out_size, void* d_ws, size_t ws_size, hipStream_t stream) {
    static int grid = 0;
    if (grid == 0) {
        if (n_in != 17 || in_sizes[0] != M * DM || out_size != M * DM || ws_size < WS_END) {
            fprintf(stderr, "kernel_launch: unexpected shapes (n_in %d, in0 %d, out %d, ws %zu < %zu); nothing launched\n", n_in, n_in > 0 ? in_sizes[0] : -1, out_size, ws_size, (size_t)WS_END); grid = -1; return; }
        int dev = 0, cus = 0, per_cu = 0;
        if (hipGetDevice(&dev) != hipSuccess || hipDeviceGetAttribute(&cus, hipDeviceAttributeMultiprocessorCount, dev) != hipSuccess) { grid = -1; return; }
        if (hipFuncSetAttribute((const void*)mk_fwd, hipFuncAttributeMaxDynamicSharedMemorySize, LDS_BYTES) != hipSuccess) { fprintf(stderr, "kernel_launch: hipFuncSetAttribute failed\n"); grid = -1; return; }
        if (hipOccupancyMaxActiveBlocksPerMultiprocessor(&per_cu, (const void*)mk_fwd, NWAVES * 64, LDS_BYTES) != hipSuccess || per_cu < 1)
            fprintf(stderr, "kernel_launch: note: occupancy query reports %d workgroups per CU\n", per_cu);
        (void)hipGetLastError();
        grid = cus;
    }
    if (grid < 0) return;
    (void)hipMemsetAsync((char*)d_ws + WS_CTL, 0, CTL_ZERO_BYTES, stream);
    Args a{};
    for (int i = 0; i < 17; ++i) a.in[i] = (const float*)d_in[i];
    a.out = (float*)d_out; a.ws = (unsigned char*)d_ws;
#if MK_N_LAUNCHES == 1
    a.ph_lo = 0; a.ph_hi = N_PHASES;
    hipLaunchKernelGGL(mk_fwd, dim3(grid), dim3(NWAVES * 64), LDS_BYTES, stream, a);
#else
    for (int p = 0; p < N_PHASES; ++p) { a.ph_lo = p; a.ph_hi = p + 1;
        for (int rep = 0; rep < (p == REP_PHASE ? 2 : 1); ++rep)
        hipLaunchKernelGGL(mk_fwd, dim3(grid), dim3(NWAVES * 64), LDS_BYTES, stream, a); }
#endif
}
```
